# Optimizing an MI355X kernel written in HIP

```python
import jax, jax.numpy as jnp
from jax import lax
import numpy as np

D_MODEL = 1024
BATCH = 4
SEQ = 8192
DEPTH = 4

N_A = DEPTH // 2
N_B = DEPTH - N_A
N_HEADS = 16
HEAD_DIM = D_MODEL // N_HEADS
CONV_W = 3
D_FF = 2816
Q_BLOCK = 128
EPS = 1e-6

kernel_name = "yoco_shortconv_fox_hybrid"


def rmsnorm(x, g):
    xf = x.astype(jnp.float32)
    y = xf * lax.rsqrt(jnp.mean(xf * xf, axis=-1, keepdims=True) + EPS)
    return (y * g).astype(x.dtype)


def causal_dwconv(u, w):
    width = w.shape[0]
    s = u.shape[1]
    up = jnp.pad(u, ((0, 0), (width - 1, 0), (0, 0)))
    return sum(up[:, i:i + s] * w[i] for i in range(width))


def short_conv_mixer(xn, w_in, conv_w, w_out):
    proj = xn @ w_in
    b, c, h = jnp.split(proj, 3, axis=-1)
    u = causal_dwconv(c * h, conv_w)
    return (b * u) @ w_out


def conv_ffn(xn, w_up, conv_w, w_down):
    up = xn @ w_up
    a, g = jnp.split(up, 2, axis=-1)
    a = causal_dwconv(a, conv_w)
    return (jax.nn.silu(a) * g) @ w_down


def forgetting_attention(q, k, v, c):
    bsz, nh, s_len, hd = q.shape
    nb = s_len // Q_BLOCK
    scale = hd ** -0.5
    qb = q.reshape(bsz, nh, nb, Q_BLOCK, hd).transpose(2, 0, 1, 3, 4)
    cb = c.reshape(bsz, nh, nb, Q_BLOCK).transpose(2, 0, 1, 3)
    kpos = jnp.arange(s_len)

    def one_block(args):
        q_i, c_i, i = args
        s = jnp.einsum('bhqd,bhkd->bhqk', q_i, k, preferred_element_type=jnp.float32) * scale
        s = s + c_i[..., None] - c[:, :, None, :]
        qpos = i * Q_BLOCK + jnp.arange(Q_BLOCK)
        s = jnp.where(kpos[None, :] <= qpos[:, None], s, -jnp.inf)
        p = jax.nn.softmax(s, axis=-1)
        return jnp.einsum('bhqk,bhkd->bhqd', p.astype(v.dtype), v)

    o = lax.map(one_block, (qb, cb, jnp.arange(nb)))
    return o.transpose(1, 0, 3, 2, 4).reshape(bsz, s_len, nh * hd)


def setup_inputs(seed: int = 0) -> dict:
    key = jax.random.key(seed)
    ks = jax.random.split(key, 17)
    f32 = jnp.float32
    out_scale = (2 * DEPTH) ** -0.5

    def nrm(k, shape, scale):
        return jax.random.normal(k, shape, f32) * scale

    def gain(k, shape):
        return 1.0 + 0.02 * jax.random.normal(k, shape, f32)

    x = nrm(ks[0], (BATCH, SEQ, D_MODEL), 1.0)
    attn_norm = gain(ks[1], (DEPTH, D_MODEL))
    ffn_norm = gain(ks[2], (DEPTH, D_MODEL))
    a_w_in = nrm(ks[3], (N_A, D_MODEL, 3 * D_MODEL), D_MODEL ** -0.5)
    a_conv = nrm(ks[4], (N_A, CONV_W, D_MODEL), CONV_W ** -0.5)
    a_w_out = nrm(ks[5], (N_A, D_MODEL, D_MODEL), out_scale * D_MODEL ** -0.5)
    kv_norm = gain(ks[6], (D_MODEL,))
    w_kvf = jnp.concatenate([
        nrm(ks[7], (D_MODEL, 2 * D_MODEL), D_MODEL ** -0.5),
        nrm(ks[8], (D_MODEL, N_HEADS), 0.1 * D_MODEL ** -0.5),
    ], axis=1)
    b_f = jax.random.uniform(ks[9], (N_HEADS,), f32, 1.0, 6.0)
    k_norm = gain(ks[10], (HEAD_DIM,))
    b_w_qg = nrm(ks[11], (N_B, D_MODEL, 2 * D_MODEL), D_MODEL ** -0.5)
    q_norm = gain(ks[12], (N_B, HEAD_DIM))
    b_w_out = nrm(ks[13], (N_B, D_MODEL, D_MODEL), out_scale * D_MODEL ** -0.5)
    ffn_w_up = nrm(ks[14], (DEPTH, D_MODEL, 2 * D_FF), D_MODEL ** -0.5)
    ffn_conv = nrm(ks[15], (DEPTH, CONV_W, D_FF), CONV_W ** -0.5)
    ffn_w_down = nrm(ks[16], (DEPTH, D_FF, D_MODEL), out_scale * D_FF ** -0.5)
    return {"x": x, "attn_norm": attn_norm, "ffn_norm": ffn_norm,
            "a_w_in": a_w_in, "a_conv": a_conv, "a_w_out": a_w_out,
            "kv_norm": kv_norm, "w_kvf": w_kvf, "b_f": b_f, "k_norm": k_norm,
            "b_w_qg": b_w_qg, "q_norm": q_norm, "b_w_out": b_w_out,
            "ffn_w_up": ffn_w_up, "ffn_conv": ffn_conv, "ffn_w_down": ffn_w_down}


def reference(x, attn_norm, ffn_norm, a_w_in, a_conv, a_w_out, kv_norm, w_kvf, b_f,
              k_norm, b_w_qg, q_norm, b_w_out, ffn_w_up, ffn_conv, ffn_w_down):
    bsz, s_len, d = x.shape
    k = v = c = None
    for l in range(DEPTH):
        if l < N_A:
            xn = rmsnorm(x, attn_norm[l])
            x = x + short_conv_mixer(xn, a_w_in[l], a_conv[l], a_w_out[l])
        else:
            if l == N_A:
                h = rmsnorm(x, kv_norm)
                kvf = h @ w_kvf
                k_s = kvf[..., :d].reshape(bsz, s_len, N_HEADS, HEAD_DIM)
                v_s = kvf[..., d:2 * d].reshape(bsz, s_len, N_HEADS, HEAD_DIM)
                f_logit = (kvf[..., 2 * d:] + b_f).astype(jnp.float32)
                k = rmsnorm(k_s, k_norm).transpose(0, 2, 1, 3)
                v = v_s.transpose(0, 2, 1, 3)
                c = jnp.cumsum(jax.nn.log_sigmoid(f_logit), axis=1).transpose(0, 2, 1)
            j = l - N_A
            xn = rmsnorm(x, attn_norm[l])
            qg = xn @ b_w_qg[j]
            q = rmsnorm(qg[..., :d].reshape(bsz, s_len, N_HEADS, HEAD_DIM), q_norm[j])
            q = q.transpose(0, 2, 1, 3)
            o = forgetting_attention(q, k, v, c)
            o = o * jax.nn.sigmoid(qg[..., d:])
            x = x + o @ b_w_out[j]
        xn = rmsnorm(x, ffn_norm[l])
        x = x + conv_ffn(xn, ffn_w_up[l], ffn_conv[l], ffn_w_down[l])
    return x
```

```cpp
#include <hip/hip_runtime.h>
#include <cstdio>
#include <cstdint>
#include <hip/hip_cooperative_groups.h>
namespace pg8 {
#define PG8_LAS __attribute__((address_space(3)))
typedef unsigned short bf16_t;
typedef short bf16x8 __attribute__((ext_vector_type(8)));
typedef float f32x4 __attribute__((ext_vector_type(4)));
typedef unsigned u32x4 __attribute__((ext_vector_type(4)));
constexpr int BM = 256, BK = 64, HALF = 128, HTB = HALF * BK * 2  , STAGE_BYTES = 8 * HTB, NXCD = 8, WGM = 4;

__host__ __device__ __forceinline__ int lds_byte(int r, int c) { const int st = (r >> 4) * 2 + (c >> 5), rr = r & 15, cc = c & 31, ob = rr * 64 + cc * 2; return st * 1024 + (ob ^ (((ob >> 9) & 1) << 5)); }
__host__ __device__ __forceinline__ void stage_rc(int b, int& R, int& C) { const int st = b / 1024, sb = b % 1024, swz = sb ^ (((sb >> 9) & 1) << 5); R = (st >> 1) * 16 + swz / 64; C = (st & 1) * 32 + (swz % 64) / 2; }
__host__ __device__ __forceinline__ int perm32(int rho) { const int n = rho >> 4, i = rho & 15; return 8 * (i >> 2) + 4 * n + (i & 3); }

struct Unit { int pm, pn, rp; };
struct Gemm { const bf16_t* A; const bf16_t* Bt; int M, N, K; };

struct StaticOrder {
    int nM, nN, nwg, G, c, rep;
    __host__ __device__ void init(int M, int N, int G_, int c_, int rep_ = 1) { nM = M / BM; nN = N / BM; nwg = nM * nN; G = G_; c = c_; rep = rep_; }
    __host__ __device__ bool next(int i, Unit& u) const {
        const long L = (long)(i / rep) * G + c; if (L >= nwg) return false;
        int wgid = (int)L; { const int q = nwg / NXCD, r = nwg % NXCD, xcd = wgid % NXCD, off = wgid / NXCD; wgid = (xcd < r ? xcd * (q + 1) : r * (q + 1) + (xcd - r) * q) + off; }
        const int nig = WGM * nN, gid = wgid / nig, fm = gid * WGM, gsz = (nM - fm) < WGM ? (nM - fm) : WGM;
        u.pm = fm + ((wgid % nig) % gsz); u.pn = (wgid % nig) / gsz; u.rp = i % rep; return true;
    }
    __device__ __forceinline__ void a_ready(const Unit&) const {}
    __device__ __forceinline__ void done(const Unit&) const {}
};

__device__ __forceinline__ unsigned cvt_pk_bf16(float lo, float hi) { unsigned r; asm volatile("v_cvt_pk_bf16_f32 %0, %1, %2" : "=v"(r) : "v"(lo), "v"(hi)); return r; }
typedef float f32x2 __attribute__((ext_vector_type(2)));
__device__ __forceinline__ f32x2 gelu_pk(f32x2 v) {
    const f32x2 av = __builtin_elementwise_abs(v), d = av * 0.2316418882f + 1.0f;
    f32x2 t; t.x = __builtin_amdgcn_rcpf(d.x); t.y = __builtin_amdgcn_rcpf(d.y);
    f32x2 q = t * 0.5307027145f + (-0.7265760135f); q = q * t + 0.7107068705f; q = q * t + (-0.142248368f); q = q * t + 0.127414796f; q = q * t;
    const f32x2 s = (v * v) * (-0.72134752044f);
    f32x2 e; e.x = __builtin_amdgcn_exp2f(s.x); e.y = __builtin_amdgcn_exp2f(s.y);
    const f32x2 m = v * (q * e), r = v - m;
    f32x2 o; o.x = v.x < 0.f ? m.x : r.x; o.y = v.y < 0.f ? m.y : r.y; return o;
}

template <int ACT  > struct EpiBf16 {
    static constexpr bool PERM = true, AFTER_DRAIN = false; static_assert(ACT == 0 || ACT == 1, "EpiBf16: ACT is 0 (none) or 1 (gelu_pk)");
    bf16_t* O; int ldc; const float* bias; int split_cols; size_t split_stride; float scale0;
    __device__ __forceinline__ void operator()(const f32x4 (&acc)[2][2][4][2], const Unit& u, int wr, int wc, int fr_, int fq_) const {
        int fr = fr_, fq = fq_; asm volatile("" : "+v"(fr), "+v"(fq));
        const int row0 = u.pm * BM + wr * 64 + fr; int colt = u.pn * BM; bf16_t* base = O;
        float sc = 1.f; if (split_cols) { const int t = colt / split_cols; base += (size_t)t * split_stride; colt -= t * split_cols; if (t == 0) sc = scale0; }
        const int col0 = colt + wc * 32 + 8 * fq, bcol0 = u.pn * BM + wc * 32 + 8 * fq;
        f32x4 bv[2][2];
#pragma unroll
        for (int bj = 0; bj < 2; ++bj)
#pragma unroll
            for (int n = 0; n < 2; ++n) bv[bj][n] = bias ? *(const f32x4*)(bias + bcol0 + bj * HALF + 4 * n) : (f32x4){0.f, 0.f, 0.f, 0.f};
#pragma unroll
        for (int ai = 0; ai < 2; ++ai)
#pragma unroll
            for (int m = 0; m < 4; ++m) { bf16_t* rowp = base + (size_t)(row0 + ai * HALF + m * 16) * ldc + col0;
#pragma unroll
                for (int bj = 0; bj < 2; ++bj) { f32x4 v0 = acc[ai][bj][m][0] + bv[bj][0], v1 = acc[ai][bj][m][1] + bv[bj][1];
                    if (ACT == 1) { f32x2 a = gelu_pk((f32x2){v0[0], v0[1]}), b = gelu_pk((f32x2){v0[2], v0[3]}), c = gelu_pk((f32x2){v1[0], v1[1]}), d = gelu_pk((f32x2){v1[2], v1[3]});
                        v0 = (f32x4){a.x, a.y, b.x, b.y}; v1 = (f32x4){c.x, c.y, d.x, d.y}; }
                    v0 = v0 * sc; v1 = v1 * sc; u32x4 w; w.x = cvt_pk_bf16(v0[0], v0[1]); w.y = cvt_pk_bf16(v0[2], v0[3]); w.z = cvt_pk_bf16(v1[0], v1[1]); w.w = cvt_pk_bf16(v1[2], v1[3]);
                    *(u32x4*)(rowp + bj * HALF) = w; } }
    }
};
__device__ __forceinline__ float rstd_of(const float* ssq, int row) { const f32x4 a = *(const f32x4*)(ssq + (size_t)row * 4); return __builtin_amdgcn_rsqf(((a[0] + a[1]) + (a[2] + a[3])) * (1.0f / 1024.0f) + 1e-6f); }
__device__ __forceinline__ float ror1f(float v) { return __builtin_bit_cast(float, __builtin_amdgcn_mov_dpp(__builtin_bit_cast(int, v), 0x121, 0xf, 0xf, false)); }
__device__ __forceinline__ float ror2f(float v) { return __builtin_bit_cast(float, __builtin_amdgcn_mov_dpp(__builtin_bit_cast(int, v), 0x122, 0xf, 0xf, false)); }
__device__ __forceinline__ float sigmoidf_fast(float v) { return __builtin_amdgcn_rcpf(1.0f + __builtin_amdgcn_exp2f(v * -1.4426950408889634f)); }

struct EpiScaleBf16 {
    static constexpr bool PERM = true, AFTER_DRAIN = false;
    bf16_t* O; int ldc; const float* ssq;
    __device__ __forceinline__ void operator()(const f32x4 (&acc)[2][2][4][2], const Unit& u, int wr, int wc, int fr_, int fq_) const {
        int fr = fr_, fq = fq_; asm volatile("" : "+v"(fr), "+v"(fq));
        const int row0 = u.pm * BM + wr * 64 + fr, col0 = u.pn * BM + wc * 32 + 8 * fq;
        float rsv[2][4];
#pragma unroll
        for (int ai = 0; ai < 2; ++ai)
#pragma unroll
            for (int m = 0; m < 4; ++m) rsv[ai][m] = rstd_of(ssq, row0 + ai * HALF + m * 16);
#pragma unroll
        for (int ai = 0; ai < 2; ++ai)
#pragma unroll
            for (int m = 0; m < 4; ++m) { const int row = row0 + ai * HALF + m * 16; const float rs = rsv[ai][m]; bf16_t* rowp = O + (size_t)row * ldc + col0;
#pragma unroll
                for (int bj = 0; bj < 2; ++bj) { const f32x4 v0 = acc[ai][bj][m][0] * rs, v1 = acc[ai][bj][m][1] * rs;
                    u32x4 w; w.x = cvt_pk_bf16(v0[0], v0[1]); w.y = cvt_pk_bf16(v0[2], v0[3]); w.z = cvt_pk_bf16(v1[0], v1[1]); w.w = cvt_pk_bf16(v1[2], v1[3]);
                    *(u32x4*)(rowp + bj * HALF) = w; } }
    }
};
struct EpiMixA {
    static constexpr bool PERM = true, AFTER_DRAIN = false;
    bf16_t* Bo; bf16_t* CH; const float* ssq;
    __device__ __forceinline__ void operator()(const f32x4 (&acc)[2][2][4][2], const Unit& u, int wr, int wc, int fr_, int fq_) const {
        int fr = fr_, fq = fq_; asm volatile("" : "+v"(fr), "+v"(fq));
        const int row0 = u.pm * BM + wr * 64 + fr;
        float rsv[2][4];
#pragma unroll
        for (int ai = 0; ai < 2; ++ai)
#pragma unroll
            for (int m = 0; m < 4; ++m) rsv[ai][m] = rstd_of(ssq, row0 + ai * HALF + m * 16);
        if (u.pn < 8) {
            const int col0 = u.pn * 128 + wc * 32 + 8 * fq;
#pragma unroll
            for (int ai = 0; ai < 2; ++ai)
#pragma unroll
                for (int m = 0; m < 4; ++m) { const float rs2 = rsv[ai][m] * rsv[ai][m]; const f32x4 v0 = acc[ai][0][m][0] * acc[ai][1][m][0] * rs2, v1 = acc[ai][0][m][1] * acc[ai][1][m][1] * rs2;
                    u32x4 w; w.x = cvt_pk_bf16(v0[0], v0[1]); w.y = cvt_pk_bf16(v0[2], v0[3]); w.z = cvt_pk_bf16(v1[0], v1[1]); w.w = cvt_pk_bf16(v1[2], v1[3]);
                    *(u32x4*)(CH + (size_t)(row0 + ai * HALF + m * 16) * 1024 + col0) = w; }
        } else {
            const int col0 = (u.pn - 8) * BM + wc * 32 + 8 * fq;
#pragma unroll
            for (int ai = 0; ai < 2; ++ai)
#pragma unroll
                for (int m = 0; m < 4; ++m) { const float rs = rsv[ai][m]; bf16_t* rowp = Bo + (size_t)(row0 + ai * HALF + m * 16) * 1024 + col0;
#pragma unroll
                    for (int bj = 0; bj < 2; ++bj) { const f32x4 v0 = acc[ai][bj][m][0] * rs, v1 = acc[ai][bj][m][1] * rs;
                        u32x4 w; w.x = cvt_pk_bf16(v0[0], v0[1]); w.y = cvt_pk_bf16(v0[2], v0[3]); w.z = cvt_pk_bf16(v1[0], v1[1]); w.w = cvt_pk_bf16(v1[2], v1[3]);
                        *(u32x4*)(rowp + bj * HALF) = w; } }
        }
    }
};
struct EpiRes {
    static constexpr bool PERM = true, AFTER_DRAIN = false;
    const float* xin32; float* xout32; bf16_t* xb; float* ssq_out; PG8_LAS float* sq_lds; int nrep;
    __device__ __forceinline__ void operator()(const f32x4 (&acc)[2][2][4][2], const Unit& u, int wr, int wc, int fr_, int fq_) const {
        int fr = fr_, fq = fq_; asm volatile("" : "+v"(fr), "+v"(fq));
        const int row0 = u.pm * BM + wr * 64 + fr, col0 = u.pn * BM + wc * 32 + 8 * fq;
#pragma unroll
        for (int ai = 0; ai < 2; ++ai) {
            u32x4 xo[4][2];
            if (!(xin32 && u.rp == 0)) {
#pragma unroll
                for (int m = 0; m < 4; ++m)
#pragma unroll
                    for (int bj = 0; bj < 2; ++bj) xo[m][bj] = *(const u32x4*)(xb + (size_t)(row0 + ai * HALF + m * 16) * 1024 + col0 + bj * HALF);
            }
#pragma unroll
            for (int m = 0; m < 4; ++m) { const int row = row0 + ai * HALF + m * 16; const size_t off = (size_t)row * 1024 + col0; float s = 0.f;
#pragma unroll
                for (int bj = 0; bj < 2; ++bj) {
                    f32x4 x0, x1;
                    if (xin32 && u.rp == 0) { x0 = *(const f32x4*)(xin32 + off + bj * HALF); x1 = *(const f32x4*)(xin32 + off + bj * HALF + 4); }
                    else { const u32x4 o = xo[m][bj];
                        x0 = (f32x4){__builtin_bit_cast(float, o.x << 16), __builtin_bit_cast(float, o.x & 0xffff0000u), __builtin_bit_cast(float, o.y << 16), __builtin_bit_cast(float, o.y & 0xffff0000u)};
                        x1 = (f32x4){__builtin_bit_cast(float, o.z << 16), __builtin_bit_cast(float, o.z & 0xffff0000u), __builtin_bit_cast(float, o.w << 16), __builtin_bit_cast(float, o.w & 0xffff0000u)}; }
                    const float sc = nrep > 1 ? 1.0f / (float)nrep : 1.0f; const f32x4 v0 = x0 + acc[ai][bj][m][0] * sc, v1 = x1 + acc[ai][bj][m][1] * sc;
                    if (xout32) { *(f32x4*)(xout32 + off + bj * HALF) = v0; *(f32x4*)(xout32 + off + bj * HALF + 4) = v1; }
                    s += (v0[0] * v0[0] + v0[1] * v0[1]) + (v0[2] * v0[2] + v0[3] * v0[3]) + (v1[0] * v1[0] + v1[1] * v1[1]) + (v1[2] * v1[2] + v1[3] * v1[3]);
                    u32x4 w; w.x = cvt_pk_bf16(v0[0], v0[1]); w.y = cvt_pk_bf16(v0[2], v0[3]); w.z = cvt_pk_bf16(v1[0], v1[1]); w.w = cvt_pk_bf16(v1[2], v1[3]);
                    if (!xout32) *(u32x4*)(xb + off + bj * HALF) = w; }
                s += __shfl_xor(s, 16); s += __shfl_xor(s, 32);
                if (fq == 0) sq_lds[(ai * HALF + wr * 64 + m * 16 + fr) * 4 + wc] = s; }
        }
        asm volatile("s_waitcnt lgkmcnt(0)" ::: "memory"); __builtin_amdgcn_s_barrier(); asm volatile("" ::: "memory");
        const int t = (wr * 4 + wc) * 64 + fq * 16 + fr;
        if (t < 256 && u.rp == nrep - 1 && !xout32) { const f32x4 p4 = *(const PG8_LAS f32x4*)(sq_lds + t * 4); ssq_out[(size_t)(u.pm * BM + t) * 4 + u.pn] = (p4[0] + p4[1]) + (p4[2] + p4[3]); }
    }
};
struct EpiQG {
    static constexpr bool PERM = true, AFTER_DRAIN = false;
    bf16_t *Q, *SG, *Kb, *Vb; const float* ssq; const float* qn; const float* kn; float qscale;
    __device__ __forceinline__ void operator()(const f32x4 (&acc)[2][2][4][2], const Unit& u, int wr, int wc, int fr_, int fq_) const {
        int fr = fr_, fq = fq_; asm volatile("" : "+v"(fr), "+v"(fq));
        const int kind = u.pn >> 2;
        const int row0 = u.pm * BM + wr * 64 + fr, colb = (u.pn & 3) * 256 + wc * 64 + 8 * fq;
        bf16_t* dst = kind == 0 ? Q : kind == 1 ? SG : kind == 2 ? Kb : Vb;
        const float* gsrc = kind == 0 ? qn : kn; const bool nrm = (kind == 0 || kind == 2); const float osc = kind == 0 ? qscale : 1.0f;
        f32x4 g[2][2];
#pragma unroll
        for (int bj = 0; bj < 2; ++bj)
#pragma unroll
            for (int n = 0; n < 2; ++n) g[bj][n] = *(const f32x4*)(gsrc + 32 * bj + 8 * fq + 4 * n);
        float rsv[2][4];
#pragma unroll
        for (int ai = 0; ai < 2; ++ai)
#pragma unroll
            for (int m = 0; m < 4; ++m) rsv[ai][m] = rstd_of(ssq, row0 + ai * HALF + m * 16);
#pragma unroll
        for (int ai = 0; ai < 2; ++ai)
#pragma unroll
            for (int m = 0; m < 4; ++m) { const int row = row0 + ai * HALF + m * 16; const float rs = rsv[ai][m];
                f32x4 v[2][2]; float ss = 0.f;
#pragma unroll
                for (int bj = 0; bj < 2; ++bj)
#pragma unroll
                    for (int n = 0; n < 2; ++n) { v[bj][n] = acc[ai][bj][m][n] * rs; const f32x4 t = v[bj][n]; ss += (t[0] * t[0] + t[1] * t[1]) + (t[2] * t[2] + t[3] * t[3]); }
                if (nrm) { ss += __shfl_xor(ss, 16); ss += __shfl_xor(ss, 32); const float r = __builtin_amdgcn_rsqf(ss * (1.0f / 64.0f) + 1e-6f) * osc;
#pragma unroll
                    for (int bj = 0; bj < 2; ++bj)
#pragma unroll
                        for (int n = 0; n < 2; ++n) v[bj][n] = v[bj][n] * r * g[bj][n]; }
                else if (kind == 1) {
#pragma unroll
                    for (int bj = 0; bj < 2; ++bj)
#pragma unroll
                        for (int n = 0; n < 2; ++n)
#pragma unroll
                            for (int e = 0; e < 4; ++e) v[bj][n][e] = sigmoidf_fast(v[bj][n][e]); }
                bf16_t* rowp = dst + (size_t)row * 1024 + colb;
#pragma unroll
                for (int bj = 0; bj < 2; ++bj) { const f32x4 v0 = v[bj][0], v1 = v[bj][1];
                    u32x4 w; w.x = cvt_pk_bf16(v0[0], v0[1]); w.y = cvt_pk_bf16(v0[2], v0[3]); w.z = cvt_pk_bf16(v1[0], v1[1]); w.w = cvt_pk_bf16(v1[2], v1[3]);
                    *(u32x4*)(rowp + 32 * bj) = w; } }
    }
};
struct EpiFfnUp {
    static constexpr bool PERM = true, AFTER_DRAIN = false;
    bf16_t* Hh; const float* ssq; const float* cw; float* edgeA; float* edgeG;
    __device__ __forceinline__ void operator()(const f32x4 (&acc)[2][2][4][2], const Unit& u, int wr, int wc, int fr_, int fq_) const {
        int fr = fr_, fq = fq_; asm volatile("" : "+v"(fr), "+v"(fq));
        constexpr int FF = 2816; constexpr float L2E = 1.4426950408889634f, LN2 = 0.6931471805599453f;
        const int ch0 = u.pn * 128 + wc * 32 + 8 * fq;
        const bool ge1 = fr >= 1, ge2 = fr >= 2;
        float rsv[2][4];
#pragma unroll
        for (int ai = 0; ai < 2; ++ai)
#pragma unroll
            for (int m = 0; m < 4; ++m) rsv[ai][m] = rstd_of(ssq, u.pm * BM + ai * HALF + wr * 64 + 16 * m + fr);
        f32x4 w0[2], w1[2], w2[2];
#pragma unroll
        for (int n = 0; n < 2; ++n) { w0[n] = *(const f32x4*)(cw + ch0 + 4 * n) * L2E; w1[n] = *(const f32x4*)(cw + FF + ch0 + 4 * n) * L2E; w2[n] = *(const f32x4*)(cw + 2 * FF + ch0 + 4 * n) * L2E; }
#pragma unroll
        for (int ai = 0; ai < 2; ++ai) {
            const int rowb = u.pm * BM + ai * HALF + wr * 64, grp = rowb >> 6;
            f32x4 p1prev[2], p2prev[2];
#pragma unroll
            for (int n = 0; n < 2; ++n) { p1prev[n] = (f32x4){0.f, 0.f, 0.f, 0.f}; p2prev[n] = (f32x4){0.f, 0.f, 0.f, 0.f}; }
#pragma unroll
            for (int m = 0; m < 4; ++m) {
                const float rs = rsv[ai][m]; u32x4 wv;
#pragma unroll
                for (int n = 0; n < 2; ++n) {
                    const f32x4 A = acc[ai][0][m][n] * rs, Gs = acc[ai][1][m][n] * rs;
                    if (m == 0 && fr < 2) { *(f32x4*)(edgeA + ((size_t)grp * 4 + fr) * FF + ch0 + 4 * n) = A; *(f32x4*)(edgeG + ((size_t)grp * 2 + fr) * FF + ch0 + 4 * n) = Gs; }
                    if (m == 3 && fr >= 14) { *(f32x4*)(edgeA + ((size_t)grp * 4 + 2 + (fr - 14)) * FF + ch0 + 4 * n) = A; }
                    f32x4 r1, r2, q1, q2;
#pragma unroll
                    for (int e = 0; e < 4; ++e) { r1[e] = ror1f(A[e]); r2[e] = ror2f(A[e]); q1[e] = ge1 ? r1[e] : p1prev[n][e]; q2[e] = ge2 ? r2[e] : p2prev[n][e]; }
                    const f32x4 c = w0[n] * q2 + w1[n] * q1 + w2[n] * A;
                    f32x4 d;
#pragma unroll
                    for (int e = 0; e < 4; ++e) d[e] = __builtin_amdgcn_exp2f(-c[e]);
                    d = d + 1.0f;
#pragma unroll
                    for (int e = 0; e < 4; ++e) d[e] = __builtin_amdgcn_rcpf(d[e]);
                    const f32x4 h = (c * d) * (Gs * LN2);
                    p1prev[n] = r1; p2prev[n] = r2;
                    if (n == 0) { wv.x = cvt_pk_bf16(h[0], h[1]); wv.y = cvt_pk_bf16(h[2], h[3]); } else { wv.z = cvt_pk_bf16(h[0], h[1]); wv.w = cvt_pk_bf16(h[2], h[3]); }
                }
                if (m > 0 || fr >= 2) *(u32x4*)(Hh + (size_t)(rowb + 16 * m + fr) * FF + ch0) = wv;
            }
        }
    }
};

template <class Epi, class Sched, bool ALIGN_EPI = false, bool SP2 = false>
__device__ __forceinline__ void gemm_phase(PG8_LAS unsigned char* lds, const Gemm g, const Sched& S, const Epi& E, const int tid) {
    const int wid = __builtin_amdgcn_readfirstlane(tid >> 6), lane = tid & 63, wr = wid >> 2, wc = wid & 3, fr = lane & 15, fq = lane >> 4;
    const int K = g.K, nt = K / BK;
    unsigned voffA[2], voffB[2];
#pragma unroll
    for (int i = 0; i < 2; ++i) { int R, C; stage_rc(tid * 16 + i * 8192, R, C); const int Rb = Epi::PERM ? ((R & ~31) + perm32(R & 31)) : R;
        voffA[i] = (unsigned)(R * K + C) * 2u; voffB[i] = (unsigned)(Rb * K + C) * 2u; }
    const size_t kstep = (size_t)(BK * 2);
    const size_t hstep = (size_t)HALF * K * 2;
    const size_t tstep = 2 * hstep;
    const unsigned ldsw = (unsigned)wid * 1024u;
    const int aoff = lds_byte(wr * 64 + fr, fq * 8), boff = lds_byte(wc * 32 + fr, fq * 8);
#define PG8_SA(b, h) (((b) * 2 + (h)) * HTB)
#define PG8_SB(b, h) ((4 + (b) * 2 + (h)) * HTB)
#define PG8_STAGE(bufoff, gbase, voff) do { _Pragma("unroll") for (int _i = 0; _i < 2; ++_i) \
        __builtin_amdgcn_global_load_lds((const unsigned*)((const char*)(gbase) + (voff)[_i]), (PG8_LAS unsigned*)(lds + (bufoff) + ldsw + _i * 8192), 16, 0, 0); } while (0)
#define PG8_LDA(dst, b, h) do { _Pragma("unroll") for (int m = 0; m < 4; ++m) _Pragma("unroll") for (int k = 0; k < 2; ++k) dst[m][k] = *(const PG8_LAS bf16x8*)(lds + PG8_SA(b, h) + aoff + m * 2048 + k * 1024); } while (0)
#define PG8_LDB(dst, b, h) do { _Pragma("unroll") for (int n = 0; n < 2; ++n) _Pragma("unroll") for (int k = 0; k < 2; ++k) dst[n][k] = *(const PG8_LAS bf16x8*)(lds + PG8_SB(b, h) + boff + n * 2048 + k * 1024); } while (0)
#define PG8_MMA(ai, bj, At, Bt) do { __builtin_amdgcn_s_setprio(1); _Pragma("unroll") for (int m = 0; m < 4; ++m) _Pragma("unroll") for (int n = 0; n < 2; ++n) _Pragma("unroll") for (int k = 0; k < 2; ++k) \
        acc[ai][bj][m][n] = __builtin_amdgcn_mfma_f32_16x16x32_bf16(Bt[n][k], At[m][k], acc[ai][bj][m][n], 0, 0, 0); __builtin_amdgcn_s_setprio(0); } while (0)
#define PG8_WAIT_V(n) asm volatile("s_waitcnt vmcnt(" #n ")" ::: "memory")
#define PG8_WAIT_L(n) asm volatile("s_waitcnt lgkmcnt(" #n ")" ::: "memory")
#define PG8_BAR __builtin_amdgcn_s_barrier()
#define PG8_SCHED __builtin_amdgcn_sched_barrier(0)
    Unit cur, nxt; int ui = 0;
    if (!S.next(0, cur)) return;
    f32x4 acc[2][2][4][2];
#pragma unroll
    for (int a = 0; a < 2; ++a)
#pragma unroll
        for (int b = 0; b < 2; ++b)
#pragma unroll
            for (int m = 0; m < 4; ++m)
#pragma unroll
                for (int n = 0; n < 2; ++n) acc[a][b][m][n] = (f32x4){0.f, 0.f, 0.f, 0.f};
    bf16x8 At[4][2], B0[2][2], B1[2][2];
    const char* cA = (const char*)g.A + (size_t)cur.pm * tstep; const char* cB = (const char*)g.Bt + (size_t)cur.pn * tstep;
    S.a_ready(cur);
    if constexpr (SP2) {
        PG8_STAGE(PG8_SB(0, 0), cB, voffB); PG8_STAGE(PG8_SB(0, 1), cB + hstep, voffB); PG8_STAGE(PG8_SA(0, 0), cA, voffA); PG8_STAGE(PG8_SA(0, 1), cA + hstep, voffA);
        if (wr == 1) PG8_BAR;
        PG8_WAIT_V(2); PG8_BAR;
        PG8_STAGE(PG8_SB(1, 0), cB + kstep, voffB); PG8_STAGE(PG8_SA(1, 0), cA + kstep, voffA); PG8_STAGE(PG8_SB(1, 1), cB + hstep + kstep, voffB);
        PG8_WAIT_V(6); PG8_BAR;
    } else {
        PG8_STAGE(PG8_SB(0, 0), cB, voffB); PG8_STAGE(PG8_SA(0, 0), cA, voffA); PG8_STAGE(PG8_SB(0, 1), cB + hstep, voffB); PG8_STAGE(PG8_SA(0, 1), cA + hstep, voffA);
        if (wr == 1) PG8_BAR;
        PG8_WAIT_V(4); PG8_BAR;
        PG8_STAGE(PG8_SB(1, 0), cB + kstep, voffB); PG8_STAGE(PG8_SA(1, 0), cA + kstep, voffA); PG8_STAGE(PG8_SB(1, 1), cB + hstep + kstep, voffB);
        PG8_WAIT_V(6); PG8_BAR;
    }
    for (;;) {
        const bool has_next = S.next(ui + 1, nxt);
        const char* nA = has_next ? (const char*)g.A + (size_t)nxt.pm * tstep : cA; const char* nB = has_next ? (const char*)g.Bt + (size_t)nxt.pn * tstep : cB;
        for (int t = 0; t < nt; t += 2) {
            const bool last = (t == nt - 2);
            const char* a1 = cA + (size_t)(t + 1) * kstep;
            const char* a2 = last ? nA : cA + (size_t)(t + 2) * kstep; const char* b2 = last ? nB : cB + (size_t)(t + 2) * kstep;
            const char* a3 = a2 + kstep; const char* b3 = b2 + kstep;
            if (last && has_next) S.a_ready(nxt);
            if constexpr (SP2) {
            PG8_LDB(B0, 0, 0); PG8_LDB(B1, 0, 1); PG8_SCHED; PG8_LDA(At, 0, 0); PG8_STAGE(PG8_SA(1, 1), a1 + hstep, voffA);
            PG8_WAIT_V(8); PG8_WAIT_L(0); PG8_BAR; PG8_MMA(0, 0, At, B0); PG8_MMA(0, 1, At, B1); PG8_BAR; PG8_SCHED;
            PG8_LDA(At, 0, 1); PG8_STAGE(PG8_SB(0, 0), b2, voffB); PG8_STAGE(PG8_SB(0, 1), b2 + hstep, voffB); PG8_STAGE(PG8_SA(0, 0), a2, voffA);
            PG8_WAIT_V(8); PG8_WAIT_L(0); PG8_BAR; PG8_MMA(1, 0, At, B0); PG8_MMA(1, 1, At, B1); PG8_BAR; PG8_SCHED;
            PG8_LDB(B0, 1, 0); PG8_LDB(B1, 1, 1); PG8_SCHED; PG8_LDA(At, 1, 0); PG8_STAGE(PG8_SA(0, 1), a2 + hstep, voffA);
            PG8_WAIT_V(8); PG8_WAIT_L(0); PG8_BAR; PG8_MMA(0, 0, At, B0); PG8_MMA(0, 1, At, B1); PG8_BAR; PG8_SCHED;
            PG8_LDA(At, 1, 1); PG8_STAGE(PG8_SB(1, 0), b3, voffB); PG8_STAGE(PG8_SB(1, 1), b3 + hstep, voffB); PG8_STAGE(PG8_SA(1, 0), a3, voffA);
            PG8_WAIT_V(8); PG8_WAIT_L(0); PG8_BAR; PG8_MMA(1, 0, At, B0); PG8_MMA(1, 1, At, B1); PG8_BAR; PG8_SCHED;
            } else {
            PG8_LDB(B0, 0, 0); PG8_SCHED; PG8_LDA(At, 0, 0); PG8_STAGE(PG8_SA(1, 1), a1 + hstep, voffA);
            PG8_WAIT_L(8); PG8_BAR; PG8_WAIT_L(0); PG8_MMA(0, 0, At, B0); PG8_BAR; PG8_SCHED;
            PG8_LDB(B1, 0, 1); PG8_STAGE(PG8_SB(0, 0), b2, voffB);
            PG8_BAR; PG8_WAIT_L(0); PG8_MMA(0, 1, At, B1); PG8_BAR;
            PG8_LDA(At, 0, 1); PG8_STAGE(PG8_SA(0, 0), a2, voffA);
            PG8_BAR; PG8_WAIT_L(0); PG8_MMA(1, 0, At, B0); PG8_BAR; PG8_SCHED;
            PG8_STAGE(PG8_SB(0, 1), b2 + hstep, voffB);
            PG8_WAIT_V(6); PG8_BAR; PG8_MMA(1, 1, At, B1); PG8_BAR;
            PG8_LDB(B0, 1, 0); PG8_SCHED; PG8_LDA(At, 1, 0); PG8_STAGE(PG8_SA(0, 1), a2 + hstep, voffA);
            PG8_WAIT_L(8); PG8_BAR; PG8_WAIT_L(0); PG8_MMA(0, 0, At, B0); PG8_BAR; PG8_SCHED;
            PG8_LDB(B1, 1, 1); PG8_STAGE(PG8_SB(1, 0), b3, voffB);
            PG8_BAR; PG8_WAIT_L(0); PG8_MMA(0, 1, At, B1); PG8_BAR;
            PG8_LDA(At, 1, 1); PG8_STAGE(PG8_SA(1, 0), a3, voffA);
            PG8_BAR; PG8_WAIT_L(0); PG8_MMA(1, 0, At, B0); PG8_BAR; PG8_SCHED;
            PG8_STAGE(PG8_SB(1, 1), b3 + hstep, voffB);
            PG8_WAIT_V(6); PG8_BAR; PG8_MMA(1, 1, At, B1); PG8_BAR;
            }
        }
        if constexpr (ALIGN_EPI) { if (wr == 0) PG8_BAR; }
        if constexpr (!Epi::AFTER_DRAIN) { E(acc, cur, wr, wc, fr, fq); S.done(cur); }
        if (!has_next) break;
#pragma unroll
        for (int a = 0; a < 2; ++a)
#pragma unroll
            for (int b = 0; b < 2; ++b)
#pragma unroll
                for (int m = 0; m < 4; ++m)
#pragma unroll
                    for (int n = 0; n < 2; ++n) acc[a][b][m][n] = (f32x4){0.f, 0.f, 0.f, 0.f};
        cur = nxt; cA = nA; cB = nB; ++ui;
        if constexpr (ALIGN_EPI) { if (wr == 1) PG8_BAR; }
    }
    PG8_WAIT_V(0);
    if constexpr (!ALIGN_EPI) { if (wr == 0) PG8_BAR; }
    PG8_BAR;
    if constexpr (Epi::AFTER_DRAIN) { E.fused(acc, cur, wr, wc, fr, fq, lds, wid, lane); S.done(cur); }
#undef PG8_SA
#undef PG8_SB
#undef PG8_STAGE
#undef PG8_LDA
#undef PG8_LDB
#undef PG8_MMA
#undef PG8_WAIT_V
#undef PG8_WAIT_L
#undef PG8_BAR
#undef PG8_SCHED
}
}

#ifndef PG8_SP2
#define PG8_SP2 true
#endif
#ifndef PG8_ALIGN
#define PG8_ALIGN true
#endif
#include <hip/hip_bf16.h>
#include <cmath>
namespace attn_body {
using bf16=__hip_bfloat16;
using bf16x8=__attribute__((ext_vector_type(8)))short;
using s16x4=__attribute__((ext_vector_type(4)))short;
using f32x16=__attribute__((ext_vector_type(16)))float;
using u32x4=__attribute__((ext_vector_type(4)))unsigned;
using f32x4v=__attribute__((ext_vector_type(4)))float;
constexpr int BATCH=4,NHEAD=16,SEQ=8192,D=64,DM=NHEAD*D;
constexpr int NW=8,QBLK=32,QB=QBLK*NW,KVBLK=64,NQB=SEQ/QB;
constexpr int ATTN_PITCH=DM, ATTN_UNIT_ROWS=QB;
__device__ __forceinline__ int crow(int r,int hi){return (r&3)+8*(r>>2)+4*hi;}
#define SBAR() __builtin_amdgcn_sched_barrier(0)
__device__ __forceinline__ void cmask(f32x16&p0,f32x16&p1,int jb,int qrel,int hi){
  const float NEG=-INFINITY; int q2=qrel-64*jb-4*hi; asm volatile("":"+v"(q2));
  #pragma unroll
  for(int r=0;r<16;++r){const int c=(r&3)+8*(r>>2); if(c>q2)p0[r]=NEG; if(c+32>q2)p1[r]=NEG;}
}

constexpr int NSLOT=3, SLOTB=8192;
constexpr int LDS_K=0, LDS_V=NSLOT*SLOTB, LDS_WS=2*NSLOT*SLOTB, LDS_OST=LDS_WS+NW*64*4, LDS_BYTES=LDS_OST+NW*4096, LDS_KX=86016, LDS_TOTAL=LDS_KX+SEQ*8;
constexpr float C2=0.125f*1.4426950408889634f;
__device__ __forceinline__ void glds16(const void*gsrc,unsigned lds_dst){unsigned keep;
  asm volatile("s_mov_b32 %0, m0\n\ts_mov_b32 m0, %2\n\ts_nop 0\n\tglobal_load_lds_dwordx4 %1, off\n\ts_mov_b32 m0, %0":"=&s"(keep):"v"(gsrc),"s"(lds_dst):"memory");}
__device__ __forceinline__ float max3f(float a,float b,float c){float r;asm("v_max3_f32 %0, %1, %2, %3":"=v"(r):"v"(a),"v"(b),"v"(c));return r;}
__device__ __forceinline__ float max2f(float a,float b){float r;asm("v_max_f32_e32 %0, %1, %2":"=v"(r):"v"(a),"v"(b));return r;}
__device__ __forceinline__ float fadd_s(float a,float b){float r;asm("v_add_f32_e32 %0, %1, %2":"=v"(r):"v"(a),"v"(b));return r;}
__device__ __forceinline__ float fsub_s(float a,float b){float r;asm("v_sub_f32_e32 %0, %1, %2":"=v"(r):"v"(a),"v"(b));return r;}
typedef float f32x2_t __attribute__((ext_vector_type(2))); typedef __bf16 bf16x2_t __attribute__((ext_vector_type(2)));
__device__ __forceinline__ unsigned cvtpk_s(float lo,float hi){f32x2_t v={lo,hi};bf16x2_t b=__builtin_convertvector(v,bf16x2_t);return __builtin_bit_cast(unsigned,b);}
#define WAIT_BAR(N) asm volatile("s_waitcnt vmcnt(" #N ") lgkmcnt(0)\n\ts_barrier":::"memory")

__device__ __forceinline__ void qkt(f32x16&p0,f32x16&p1,const char*Kslot,const bf16x8*qr,const f32x16&negm,int r32,int hi){
  const char*kb=Kslot+hi*1024+r32*16;
  #pragma unroll
  for(int d0=0;d0<4;++d0){
    const bf16x8 b0=*reinterpret_cast<const bf16x8*>(kb+d0*2048);
    const bf16x8 b1=*reinterpret_cast<const bf16x8*>(kb+d0*2048+512);
    if(d0==0){p0=__builtin_amdgcn_mfma_f32_32x32x16_bf16(b0,qr[0],f32x16{},0,0,0);p1=__builtin_amdgcn_mfma_f32_32x32x16_bf16(b1,qr[0],f32x16{},0,0,0);}
    else{p0=__builtin_amdgcn_mfma_f32_32x32x16_bf16(b0,qr[d0],p0,0,0,0);p1=__builtin_amdgcn_mfma_f32_32x32x16_bf16(b1,qr[d0],p1,0,0,0);}}
}
typedef __attribute__((address_space(3))) const char* lds_cptr;
typedef short v4i16_t __attribute__((ext_vector_type(4)));
__device__ __forceinline__ void kload8(bf16x8*kf,lds_cptr kp){
  kf[0]=*(const __attribute__((address_space(3))) bf16x8*)(kp);      kf[1]=*(const __attribute__((address_space(3))) bf16x8*)(kp+512);
  kf[2]=*(const __attribute__((address_space(3))) bf16x8*)(kp+2048); kf[3]=*(const __attribute__((address_space(3))) bf16x8*)(kp+2560);
  kf[4]=*(const __attribute__((address_space(3))) bf16x8*)(kp+4096); kf[5]=*(const __attribute__((address_space(3))) bf16x8*)(kp+4608);
  kf[6]=*(const __attribute__((address_space(3))) bf16x8*)(kp+6144); kf[7]=*(const __attribute__((address_space(3))) bf16x8*)(kp+6656);
}
__device__ __forceinline__ void kload2(bf16x8*kf,lds_cptr kp,int j){ kf[2*j]=*(const __attribute__((address_space(3))) bf16x8*)(kp+j*2048); kf[2*j+1]=*(const __attribute__((address_space(3))) bf16x8*)(kp+j*2048+512); }
__device__ __forceinline__ s16x4 vtr(lds_cptr p){ return __builtin_bit_cast(s16x4,__builtin_amdgcn_ds_read_tr16_b64_v4i16((__attribute__((address_space(3))) v4i16_t*)p)); }
__device__ __forceinline__ float rowmax(const f32x16&p0,const f32x16&p1){
  float a=max3f(p0[0],p0[1],p1[0]),b=max3f(p0[2],p0[3],p1[1]);a=max3f(a,p1[2],p1[3]);
  #pragma unroll
  for(int r=4;r<16;r+=4){a=max3f(a,p0[r],p0[r+1]);b=max3f(b,p0[r+2],p0[r+3]);a=max3f(a,p1[r],p1[r+1]);b=max3f(b,p1[r+2],p1[r+3]);}
  const float m=max2f(a,b);
  auto rr=__builtin_amdgcn_permlane32_swap(__float_as_uint(m),__float_as_uint(m),false,false);
  return max2f(__uint_as_float(rr[0]),__uint_as_float(rr[1]));
}
__device__ __forceinline__ void pv(f32x16*o,int vb,bf16x8 pa0,bf16x8 pa1,bf16x8 pa2,bf16x8 pa3){
  #pragma unroll
  for(int d0=0;d0<2;++d0){s16x4 lo[4],hi[4];
    #pragma unroll
    for(int ks=0;ks<4;++ks){
      asm volatile("ds_read_b64_tr_b16 %0,%1 offset:%c2":"=&v"(lo[ks]):"v"(vb),"i"(d0*4096+ks*1024):"memory");
      asm volatile("ds_read_b64_tr_b16 %0,%1 offset:%c2":"=&v"(hi[ks]):"v"(vb),"i"(d0*4096+ks*1024+512):"memory");}
    asm volatile("s_waitcnt lgkmcnt(0)":::"memory");SBAR();
    #define PK(k) (bf16x8){lo[k][0],lo[k][1],lo[k][2],lo[k][3],hi[k][0],hi[k][1],hi[k][2],hi[k][3]}
    o[d0]=__builtin_amdgcn_mfma_f32_32x32x16_bf16(pa0,PK(0),o[d0],0,0,0);
    o[d0]=__builtin_amdgcn_mfma_f32_32x32x16_bf16(pa1,PK(1),o[d0],0,0,0);
    o[d0]=__builtin_amdgcn_mfma_f32_32x32x16_bf16(pa2,PK(2),o[d0],0,0,0);
    o[d0]=__builtin_amdgcn_mfma_f32_32x32x16_bf16(pa3,PK(3),o[d0],0,0,0);
    #undef PK
  }
}

#ifndef ATTN_STORE16
#define ATTN_STORE16(p,v) (*(u32x4*)(p)=(v))
#endif
template<int THRL> __device__ __forceinline__ void attn_unit(int b,int h,int qb,const bf16*Q,const bf16*__restrict__ K,const bf16*__restrict__ V,bf16*O,const bf16*SG,const unsigned*KXG,const int j0,const float BND,char*shm,const int tid,const bool kv0=false){
  const int lane=tid&63,r32=lane&31,hi=lane>>5; const int wid=__builtin_amdgcn_readfirstlane(tid>>6);
  const long rowbase=(long)b*SEQ; const int q0=qb*QB;
  const bf16*Qw=Q+(rowbase+q0+wid*QBLK)*DM+h*D;
  const int NT0=(q0+QB)/KVBLK;
  const bf16*Kh=K+((kv0?0l:rowbase)+(long)j0*KVBLK)*DM+(kv0?0:h)*D,*Vh=V+((kv0?0l:rowbase)+(long)j0*KVBLK)*DM+(kv0?0:h)*D;
  const unsigned lds0=(unsigned)(uintptr_t)shm;
  float*wsf=(float*)(shm+LDS_WS)+wid*64;
  const bf16*ksrc=Kh+(long)lane*DM+wid*8;
  const bf16*vsrc=Vh+(long)(16*(wid&3)+(lane>>2))*DM+(wid>>2)*32+(lane&3)*8;
  const unsigned kdst=lds0+LDS_K+wid*1024, vdst=lds0+LDS_V+wid*1024;
  #define DMA_K(t,slot) glds16(ksrc+(long)(t)*KVBLK*DM,(unsigned)__builtin_amdgcn_readfirstlane(kdst+(slot)))
  #define DMA_V(t,slot) glds16(vsrc+(long)(t)*KVBLK*DM,(unsigned)__builtin_amdgcn_readfirstlane(vdst+(slot)))
  const int vb0=(int)(lds0+LDS_V)+((lane>>4)&1)*32+(lane&3)*8+(4*hi+((lane&15)>>2))*64;
  const char*Kbase=shm+LDS_K; bf16x8 kf[8];
  const lds_cptr shm3=(lds_cptr)shm; const lds_cptr kp0=shm3+LDS_K+hi*1024+r32*16; const lds_cptr vp0=shm3+LDS_V+((lane>>4)&1)*32+(lane&3)*8+(4*hi+((lane&15)>>2))*64;
  const int NT=NT0-j0;
  DMA_K(0,0);DMA_V(0,0);DMA_K(1,SLOTB);
  bf16x8 qr[4];
  #pragma unroll
  for(int d0=0;d0<4;++d0)qr[d0]=*reinterpret_cast<const bf16x8*>(&Qw[(long)r32*DM+d0*16+hi*8]);
  float mhat=0.f,l_reg=0.f;f32x16 o[2];o[0]=f32x16{};o[1]=f32x16{};f32x16 negm=f32x16{};
  const int qrel=wid*QBLK+r32;
  #define CMASK(P0,P1,t) do{int jb_=(t)-(NT-4); if(jb_>=0)cmask(P0,P1,jb_,qrel,hi);}while(0)
  #define START(P0,P1) do{ _Pragma("unroll") for(int r=0;r<16;++r)P0[r]=__builtin_amdgcn_exp2f(P0[r]); }while(0)
  #define RESC() do{}while(0)
  f32x16 pA0,pA1,pB0,pB1;
  int sl_prev=0,sl_cur=0,sl_next=SLOTB;
  #define ROT() do{sl_prev=sl_cur;sl_cur=sl_next;sl_next=(sl_next==(NSLOT-1)*SLOTB)?0:sl_next+SLOTB;}while(0)
  typedef __attribute__((address_space(3))) char lds_char; typedef __attribute__((ext_vector_type(2))) unsigned u32x2v;
  typedef __attribute__((address_space(3))) u32x4 lds_u32x4; typedef __attribute__((address_space(3))) u32x2v lds_u32x2;
  lds_char* const kx3=(lds_char*)shm+LDS_KX+j0*512;
  { lds_char* const kxw=(lds_char*)shm+LDS_KX; const u32x4* kxs=(const u32x4*)(KXG+(long)(b*NHEAD+h)*SEQ*2);
    int tid_n=tid; asm volatile("":"+v"(tid_n));
    for(int p_=j0*(KVBLK/2)+tid_n;p_<(q0+QB)/2;p_+=NW*64){ *(lds_u32x4*)(kxw+p_*16)=kxs[p_]; } }
  u32x4 qxv=(hi==0)?(u32x4){0x3f803f80u,0x00003f80u,0u,0u}:(u32x4){0u,0u,0u,0u};
  #define qx __builtin_bit_cast(bf16x8,qxv)
  #define SETQX() do{ const float nm_=-mhat; const unsigned h_=cvtpk_s(nm_,0.f)&0xffffu; const float r1_=nm_-__uint_as_float(h_<<16); const unsigned m_=cvtpk_s(r1_,0.f)&0xffffu; \
    const float r2_=r1_-__uint_as_float(m_<<16); const unsigned l_=cvtpk_s(r2_,0.f)&0xffffu; qxv.y=(hi==0)?(0x3f80u|(h_<<16)):0u; qxv.z=(hi==0)?(m_|(l_<<16)):0u; }while(0)
  u32x2v kxa,kxb;
  #define KXLD(t) do{ const lds_u32x2* p_=(const lds_u32x2*)(kx3+(t)*512+r32*8); kxa=p_[0]; kxb=p_[32]; }while(0)
  #define KXF(v) __builtin_bit_cast(bf16x8,(u32x4){(v).x,(v).y,0x3f803f80u,0u})
  { const unsigned* kq_=KXG+((long)(b*NHEAD+h)*SEQ+q0+wid*QBLK+r32)*2; const unsigned w0_=kq_[0], w1_=kq_[1];
    mhat=(__uint_as_float(w0_<<16)+__uint_as_float(w0_&0xffff0000u))+__uint_as_float(w1_<<16)+BND; SETQX(); }
  DMA_K(2,2*SLOTB);
  WAIT_BAR(3);
  KXLD(0); qkt(pA0,pA1,Kbase,qr,negm,r32,hi); pA0=__builtin_amdgcn_mfma_f32_32x32x16_bf16(KXF(kxa),qx,pA0,0,0,0); pA1=__builtin_amdgcn_mfma_f32_32x32x16_bf16(KXF(kxb),qx,pA1,0,0,0);
  asm volatile("s_nop 15\n\ts_nop 7":"+v"(pA0),"+v"(pA1));CMASK(pA0,pA1,0);
  START(pA0,pA1);
  _Pragma("unroll") for(int r=0;r<16;++r)pA1[r]=__builtin_amdgcn_exp2f(pA1[r]);
  WAIT_BAR(0);
  DMA_K(3,0);DMA_V(1,SLOTB);
  ROT();
  kload8(kf,kp0+sl_cur); KXLD(1);
  WAIT_BAR(2);
  s16x4 vlo[8],vhi[8]; u32x4 pw0,pw1,pw2,pw3;
  #define PKW(P,B) cvtpk_s(P[B],P[B+1])
  #define PAF(k) __builtin_bit_cast(bf16x8,pw##k)
  #define VFR(i) (bf16x8){vlo[i][0],vlo[i][1],vlo[i][2],vlo[i][3],vhi[i][0],vhi[i][1],vhi[i][2],vhi[i][3]}
  #define PIN(x) asm volatile("":"+v"(x))
  #define MX3(a,b,c) __builtin_fmaxf(__builtin_fmaxf((a),(b)),(c))
  #define GAPA(MF,A0,A1,A2,A3,W0,W1,PW) do{ MF; sacc+=A0; sacc+=A1; sacc+=A2; sacc+=A3; PIN(sacc); W0; W1; PIN(PW); SBAR(); }while(0)
  #define EX(v) __builtin_amdgcn_exp2f(v)
  #define GAPB(MF,X,B) do{ MF; X[B]=EX(X[B]); X[B+1]=EX(X[B+1]); X[B+2]=EX(X[B+2]); X[B+3]=EX(X[B+3]); PIN(X); SBAR(); }while(0)
  #define VRD(i) do{ vlo[i]=vtr(vp_+(((i)>>2)*4096+((i)&3)*1024)); vhi[i]=vtr(vp_+(((i)>>2)*4096+((i)&3)*1024+512)); }while(0)
  #define KRD(G,j) do{ if(G){ kload2(kf,kp0+sl_next,j); SBAR(); } }while(0)
  #define KXRD(G,t) do{ if(G){ KXLD((t)+1); SBAR(); } }while(0)
  #define STEP(C0,C1,P0,P1,t,GK,GV,GL) do{ SBAR(); \
    const lds_cptr vp_=vp0+sl_prev; \
    VRD(0); SBAR(); float sacc=(P0[0]+P0[1]); \
    GAPA(C0=__builtin_amdgcn_mfma_f32_32x32x16_bf16(kf[0],qr[0],f32x16{},0,0,0), P0[2],P0[3],P0[4],P0[5],     pw0[0]=PKW(P0,0), pw0[1]=PKW(P0,2), pw0); \
    VRD(4); SBAR(); GAPA(C1=__builtin_amdgcn_mfma_f32_32x32x16_bf16(kf[1],qr[0],f32x16{},0,0,0), P0[6],P0[7],P0[8],P0[9],     pw0[2]=PKW(P0,4), pw0[3]=PKW(P0,6), pw0); \
    VRD(1); SBAR(); GAPA(C0=__builtin_amdgcn_mfma_f32_32x32x16_bf16(kf[2],qr[1],C0,0,0,0),   P0[10],P0[11],P0[12],P0[13], pw1[0]=PKW(P0,8), pw1[1]=PKW(P0,10), pw1); \
    VRD(5); SBAR(); GAPA(C1=__builtin_amdgcn_mfma_f32_32x32x16_bf16(kf[3],qr[1],C1,0,0,0),   P0[14],P0[15],P1[0],P1[1],   pw1[2]=PKW(P0,12),pw1[3]=PKW(P0,14), pw1); \
    VRD(2); SBAR(); GAPA(C0=__builtin_amdgcn_mfma_f32_32x32x16_bf16(kf[4],qr[2],C0,0,0,0),   P1[2],P1[3],P1[4],P1[5],     pw2[0]=PKW(P1,0), pw2[1]=PKW(P1,2), pw2); \
    VRD(6); SBAR(); GAPA(C1=__builtin_amdgcn_mfma_f32_32x32x16_bf16(kf[5],qr[2],C1,0,0,0),   P1[6],P1[7],P1[8],P1[9],     pw2[2]=PKW(P1,4), pw2[3]=PKW(P1,6), pw2); \
    VRD(3); SBAR(); GAPA(C0=__builtin_amdgcn_mfma_f32_32x32x16_bf16(kf[6],qr[3],C0,0,0,0),   P1[10],P1[11],P1[12],P1[13], pw3[0]=PKW(P1,8), pw3[1]=PKW(P1,10), pw3); \
    VRD(7); SBAR(); GAPA(C1=__builtin_amdgcn_mfma_f32_32x32x16_bf16(kf[7],qr[3],C1,0,0,0),   P1[14],P1[15],0.f,0.f,       pw3[2]=PKW(P1,12),pw3[3]=PKW(P1,14), pw3); \
    C0=__builtin_amdgcn_mfma_f32_32x32x16_bf16(KXF(kxa),qx,C0,0,0,0); C1=__builtin_amdgcn_mfma_f32_32x32x16_bf16(KXF(kxb),qx,C1,0,0,0); SBAR(); \
    l_reg+=sacc; \
    if(GK){DMA_K((t)+3,sl_cur);} if(GV){DMA_V((t)+1,sl_next);} \
    CMASK(C0,C1,t); \
    SBAR(); \
    GAPB(o[0]=__builtin_amdgcn_mfma_f32_32x32x16_bf16(PAF(0),VFR(0),o[0],0,0,0), C0,0); \
    GAPB(o[1]=__builtin_amdgcn_mfma_f32_32x32x16_bf16(PAF(0),VFR(4),o[1],0,0,0), C0,4); \
    KRD(GL,0); GAPB(o[0]=__builtin_amdgcn_mfma_f32_32x32x16_bf16(PAF(1),VFR(1),o[0],0,0,0), C0,8); \
    KRD(GL,1); GAPB(o[1]=__builtin_amdgcn_mfma_f32_32x32x16_bf16(PAF(1),VFR(5),o[1],0,0,0), C0,12); \
    KRD(GL,2); GAPB(o[0]=__builtin_amdgcn_mfma_f32_32x32x16_bf16(PAF(2),VFR(2),o[0],0,0,0), C1,0); \
    KRD(GL,3); GAPB(o[1]=__builtin_amdgcn_mfma_f32_32x32x16_bf16(PAF(2),VFR(6),o[1],0,0,0), C1,4); KXRD(GL,t); \
    GAPB(o[0]=__builtin_amdgcn_mfma_f32_32x32x16_bf16(PAF(3),VFR(3),o[0],0,0,0), C1,8); \
    GAPB(o[1]=__builtin_amdgcn_mfma_f32_32x32x16_bf16(PAF(3),VFR(7),o[1],0,0,0), C1,12); \
    }while(0)
  int t=1;
  #undef CMASK
  #define CMASK(P0,P1,t) do{}while(0)
  for(;t+5<NT;t+=2){
    STEP(pB0,pB1,pA0,pA1,t,true,true,true);     WAIT_BAR(2); RESC(); ROT();
    STEP(pA0,pA1,pB0,pB1,t+1,true,true,true);   WAIT_BAR(2); RESC(); ROT();
  }
  #undef CMASK
  #define CMASK(P0,P1,t) do{int jb_=(t)-(NT-4); if(jb_>=0)cmask(P0,P1,jb_,qrel,hi);}while(0)
  #define ENDW(tt) do{ if((tt)+3<NT){WAIT_BAR(2);} else if((tt)+2<NT){WAIT_BAR(1);} else {WAIT_BAR(0);} }while(0)
  for(;t+1<NT;t+=2){
    STEP(pB0,pB1,pA0,pA1,t,(t+3<NT),(t+1<NT),(t+1<NT));       ENDW(t);   RESC(); ROT();
    STEP(pA0,pA1,pB0,pB1,t+1,(t+4<NT),(t+2<NT),(t+2<NT));     ENDW(t+1); RESC(); ROT();
  }
  STEP(pB0,pB1,pA0,pA1,NT-1,false,false,false); RESC();
  { float sacc=pB0[0]+pB0[1]; _Pragma("unroll") for(int r=2;r<16;++r)sacc+=pB0[r]; _Pragma("unroll") for(int r=0;r<16;++r)sacc+=pB1[r]; l_reg+=sacc;
    pw0=(u32x4){PKW(pB0,0),PKW(pB0,2),PKW(pB0,4),PKW(pB0,6)};pw1=(u32x4){PKW(pB0,8),PKW(pB0,10),PKW(pB0,12),PKW(pB0,14)};pw2=(u32x4){PKW(pB1,0),PKW(pB1,2),PKW(pB1,4),PKW(pB1,6)};pw3=(u32x4){PKW(pB1,8),PKW(pB1,10),PKW(pB1,12),PKW(pB1,14)};
    SBAR(); pv(o,vb0+sl_cur,PAF(0),PAF(1),PAF(2),PAF(3)); }
  #undef PKW
  #undef PAF
  #undef VFR
  #undef PIN
  #undef MX3
  #undef GAPA
  #undef GAPB
  #undef EX
  #undef VRD
  #undef KRD
  #undef STEP
  #undef ENDW
  {auto rr=__builtin_amdgcn_permlane32_swap(__float_as_uint(l_reg),__float_as_uint(l_reg),false,false);l_reg=__uint_as_float(rr[0])+__uint_as_float(rr[1]);}
  if(hi==0)wsf[32+r32]=l_reg;asm volatile("s_waitcnt lgkmcnt(0)":::"memory");
  float rli[16];
  #pragma unroll
  for(int r=0;r<16;++r)rli[r]=__builtin_amdgcn_rcpf(wsf[32+crow(r,hi)]);
  bf16*Ow=O+(rowbase+q0+wid*QBLK)*DM+h*D; const long sgd=(const char*)SG-(const char*)O;

  { bf16*stg=(bf16*)(shm+LDS_OST)+wid*2048;
    #pragma unroll
    for(int r=0;r<16;++r){const int orow=crow(r,hi);
      #pragma unroll
      for(int d0=0;d0<2;++d0)stg[orow*64+d0*32+r32]=__float2bfloat16(o[d0][r]*rli[r]);}
    asm volatile("s_waitcnt lgkmcnt(0)":::"memory");
    int lane_e=lane; asm volatile("":"+v"(lane_e));
    u32x4 gvv[4];
    #pragma unroll
    for(int i=0;i<4;++i)gvv[i]=*(const u32x4*)((const char*)(Ow+(long)(i*8+(lane_e>>3))*DM+(lane_e&7)*8)+sgd);
    #pragma unroll
    for(int i=0;i<4;++i){const int row=i*8+(lane_e>>3),ch=lane_e&7; u32x4 v=*(const u32x4*)(stg+row*64+ch*8); const u32x4 gvi=gvv[i];
      #pragma unroll
      for(int k=0;k<4;++k){ const float lo_=__builtin_bit_cast(float,v[k]<<16)*__builtin_bit_cast(float,gvi[k]<<16), hi_=__builtin_bit_cast(float,v[k]&0xffff0000u)*__builtin_bit_cast(float,gvi[k]&0xffff0000u); v[k]=cvtpk_s(lo_,hi_); }
      ATTN_STORE16(Ow+(long)row*DM+ch*8,v);} }
  asm volatile("s_waitcnt lgkmcnt(0)\n\ts_barrier":::"memory");
  #undef KXLD
  #undef qx
  #undef SETQX
  #undef KXF
  #undef KXRD
  #undef DMA_K
  #undef DMA_V
  #undef CMASK
  #undef START
  #undef RESC
  #undef ROT
}
constexpr int ATTN_LDS_BYTES=LDS_BYTES;
struct AttnTensors { const bf16* Q; const bf16* K; const bf16* V; bf16* O; const bf16* SG; const unsigned* KXG; const unsigned* J0T; };
struct AttnUnit { int bh; int qb; };
struct StaticOrder {
  int vcu;
  __device__ __forceinline__ explicit StaticOrder(int grid,int block):vcu((block%8)*(grid/8)+block/8){}
  __device__ __forceinline__ bool next(int i,AttnUnit&u)const{ if(i>=8)return false; const int s=vcu&7,j=i&3; u.bh=(vcu>>3)+32*(i>>2); u.qb=(j==0)?s:(j==1)?15-s:(j==2)?16+s:31-s; return true; }
  __device__ __forceinline__ void a_ready(const AttnUnit&)const{}
  __device__ __forceinline__ void done(const AttnUnit&)const{}
};
constexpr int LDS_QW=LDS_TOTAL, LDS_J0=LDS_TOTAL+16, LDS_ATT_END=LDS_J0+BATCH*NHEAD*NQB*4;
template<int THRL=8> __device__ __forceinline__ void attn_phase(char*lds,const AttnTensors&T,unsigned*ctr,const float BND,const int tid,const bool kv0=false){
  volatile __attribute__((address_space(3))) unsigned* qw=(volatile __attribute__((address_space(3))) unsigned*)((__attribute__((address_space(3))) char*)lds+LDS_QW);
  unsigned nxt=0u;
  volatile __attribute__((address_space(3))) unsigned* j0l=(volatile __attribute__((address_space(3))) unsigned*)((__attribute__((address_space(3))) char*)lds+LDS_J0);
  for(int i_=tid;i_<BATCH*NHEAD*NQB;i_+=NW*64)j0l[i_]=T.J0T[i_];
  if(tid==0){ qw[0]=__hip_atomic_fetch_add(ctr,1u,__ATOMIC_RELAXED,__HIP_MEMORY_SCOPE_AGENT); }
  asm volatile("s_waitcnt vmcnt(0) lgkmcnt(0)\n\ts_barrier":::"memory");
  unsigned cur=(unsigned)__builtin_amdgcn_readfirstlane((int)qw[0]);
  while(cur<(unsigned)(BATCH*NHEAD*NQB)){
    if(tid==0) nxt=__hip_atomic_fetch_add(ctr,1u,__ATOMIC_RELAXED,__HIP_MEMORY_SCOPE_AGENT);
    const int bh=(int)(cur&63u), qb=NQB-1-(int)(cur>>6);
    attn_unit<THRL>(bh/NHEAD,bh%NHEAD,qb,T.Q,T.K,T.V,T.O,T.SG,T.KXG,__builtin_amdgcn_readfirstlane((int)j0l[bh*NQB+qb]),BND,lds,tid,kv0);
    if(tid==0) qw[0]=nxt;
    asm volatile("s_waitcnt vmcnt(0) lgkmcnt(0)\n\ts_barrier":::"memory");
    cur=(unsigned)__builtin_amdgcn_readfirstlane((int)qw[0]);
  }
}
#undef SBAR
#undef WAIT_BAR
}
namespace cg = cooperative_groups;
#ifndef PROBE_X
#define PROBE_X 0
#endif
#ifndef MK_MULTI
#define MK_MULTI 0
#endif
constexpr int NWAVES = 8, NTHREADS = NWAVES * 64;
constexpr int BATCH = 4, T = 8192, D = 1024, H = 16, HD = 64, FF = 2816, M = BATCH * T;
constexpr int N_PHASES = 22;
constexpr size_t MiB = 1u << 20;
constexpr size_t WS_CTL = 1536 * 1024, CTL_BYTES = 16384;
constexpr size_t WS_WF = 2 * MiB;
constexpr size_t WS_WIN = 4 * MiB, WS_WOUT = 16 * MiB, WS_WQGKV = 20 * MiB, WS_WQG3 = 28 * MiB, WS_WBO = 32 * MiB, WS_WUP = 36 * MiB, WS_WDN = 80 * MiB;
constexpr size_t WS_XB = 104 * MiB;
constexpr size_t WS_K = 168 * MiB, WS_V = 232 * MiB;
constexpr size_t WS_ACT = 296 * MiB;
constexpr size_t WS_SG = WS_ACT + 64 * MiB;
constexpr size_t WS_EDGEA = 472 * MiB, WS_EDGEG = 494 * MiB;
constexpr size_t WS_FLT = 505 * MiB, WS_CT = 507 * MiB, WS_END = 509 * MiB;
static_assert(WS_WDN + 4 * (size_t)FF * D * 2 <= WS_XB && WS_ACT + (size_t)M * FF * 2 <= WS_EDGEA && WS_EDGEA + 512ull * 4 * FF * 4 <= WS_EDGEG && WS_EDGEG + 512ull * 2 * FF * 4 <= WS_FLT, "d_ws map");
constexpr int RING_BYTES = 131072, LDS_BYTES = 163840, LDS_BARST = LDS_BYTES - 16;
static_assert(attn_body::LDS_ATT_END <= LDS_BYTES - 16, "LDS map");

#define LAS __attribute__((address_space(3)))
typedef unsigned short bf16;
typedef unsigned v4u __attribute__((ext_vector_type(4)));
typedef unsigned v2u __attribute__((ext_vector_type(2)));
typedef float f32x4 __attribute__((ext_vector_type(4)));
typedef short bf16x8 __attribute__((ext_vector_type(8)));
#define LDS_WAIT() asm volatile("s_waitcnt lgkmcnt(0)" ::: "memory")
__device__ __forceinline__ unsigned f2bf(float f) { unsigned u = __builtin_bit_cast(unsigned, f); return (u + 0x7fffu + ((u >> 16) & 1u)) >> 16; }
__device__ __forceinline__ unsigned pk2(float lo, float hi) { return f2bf(lo) | (f2bf(hi) << 16); }
__device__ __forceinline__ float bflo(unsigned u) { return __builtin_bit_cast(float, u << 16); }
__device__ __forceinline__ float bfhi(unsigned u) { return __builtin_bit_cast(float, u & 0xffff0000u); }
__device__ __forceinline__ float wave_sum(float v) {
#pragma unroll
    for (int o = 1; o < 64; o <<= 1) v += __shfl_xor(v, o);
    return v;
}
__device__ __forceinline__ void tr_item(const float* W, int ldw, int k0, int n0, const float* gain, bf16* WT, int Kd, int drow0, int nvalid, LAS float* scr, int lane) {
    int cc = n0 + (lane & 31); if (cc >= ldw) cc = ldw - 1;
#pragma unroll 8
    for (int i = 0; i < 32; ++i) { const int kk = 2 * i + (lane >> 5); float w = W[(size_t)(k0 + kk) * ldw + cc]; if (gain) w *= gain[k0 + kk]; scr[kk * 33 + (lane & 31)] = w; }
    LDS_WAIT(); asm volatile("" ::: "memory");
    const int c = lane & 7;
#pragma unroll
    for (int j = 0; j < 4; ++j) { const int n = (lane >> 3) + 8 * j; const LAS float* s = scr + (8 * c) * 33 + n;
        v4u o; o.x = pk2(s[0 * 33], s[1 * 33]); o.y = pk2(s[2 * 33], s[3 * 33]); o.z = pk2(s[4 * 33], s[5 * 33]); o.w = pk2(s[6 * 33], s[7 * 33]);
        if (n < nvalid) *(v4u*)(WT + (size_t)(drow0 + n) * Kd + k0 + 8 * c) = o; }
    LDS_WAIT(); asm volatile("" ::: "memory");
}
__device__ __forceinline__ int headperm_row(int L0) { const int pn = L0 >> 8, w = L0 & 255; return 256 * pn + 128 * ((w & 63) >> 5) + 32 * (w >> 6); }
__device__ __forceinline__ int ffnup_row(int L0) { const int g = L0 >= FF ? 1 : 0, ch = L0 - g * FF; return 256 * (ch >> 7) + 128 * g + (ch & 127); }

#define XB_TMO      128
#define XB_XCNT(j)  (256  + 64 * (j))
#define XB_XSUB(j)  (1280 + 64 * (j))
#define XB_XGEN(j)  (2304 + 64 * (j))
#define XB_TOP      3328
#define XB_TOPGEN   3392
#define XCD_BAR_WORDS 3456
#define XB_SPIN_CAP (1u << 18)

__device__ __forceinline__ unsigned xb_ld(unsigned* p)              { return __hip_atomic_load(p, __ATOMIC_RELAXED, __HIP_MEMORY_SCOPE_AGENT); }
__device__ __forceinline__ unsigned xb_add(unsigned* p, unsigned v) { return __hip_atomic_fetch_add(p, v, __ATOMIC_RELAXED, __HIP_MEMORY_SCOPE_AGENT); }
__device__ __forceinline__ unsigned xb_xcc_id() { return (unsigned)__builtin_amdgcn_s_getreg((3 << 11) | 20) & 0xFu; }
#define XB_SPIN(cond, bar) do { unsigned _sp = 0; while (cond) { __builtin_amdgcn_s_sleep(1); \
    if ((++_sp & 255u) == 0u) { if (xb_ld(&(bar)[XB_TMO])) break; if (_sp > XB_SPIN_CAP) { atomicAdd(&(bar)[XB_TMO], 1u); break; } } } } while (0)

struct XcdBarrier {
    unsigned* bar; unsigned x;
    volatile LAS unsigned* st;
};

__device__ __forceinline__ XcdBarrier xcd_barrier_post(unsigned* bar, volatile LAS unsigned* st) {
    XcdBarrier b; b.bar = bar; b.x = xb_xcc_id(); b.st = st;
    if (threadIdx.x == 0) (void)xb_add(&bar[XB_XCNT(b.x)], 1u);
    return b;
}
__device__ __forceinline__ void xcd_barrier_complete(unsigned* bar, unsigned x, unsigned& nloc, unsigned& nx) {
    const unsigned G = gridDim.x * gridDim.y * gridDim.z;
    unsigned sum, cnt, mine, sp = 0u;
    for (;;) {
        sum = 0u; cnt = 0u; mine = 0u;
#pragma unroll
        for (unsigned j = 0; j < 16; ++j) { const unsigned c = xb_ld(&bar[XB_XCNT(j)]); sum += c; cnt += (c > 0u) ? 1u : 0u; mine = (j == x) ? c : mine; }
        if (sum == G) break;
        __builtin_amdgcn_s_sleep(1);
        if ((++sp & 255u) == 0u) { if (xb_ld(&bar[XB_TMO])) break; if (sp > XB_SPIN_CAP) { atomicAdd(&bar[XB_TMO], 1u); break; } }
    }
    nloc = mine > 0u ? mine : 1u; nx = cnt > 0u ? cnt : 1u;
}

__device__ __forceinline__ void xcd_barrier(const XcdBarrier& b) {
    asm volatile("s_waitcnt vmcnt(0)" ::: "memory");
    __syncthreads();
    if (threadIdx.x == 0) {
        unsigned* bar = b.bar;
        __builtin_amdgcn_s_waitcnt(0);
        unsigned nloc = b.st[0], nx = b.st[1];
        if (nloc == 0u) { xcd_barrier_complete(bar, b.x, nloc, nx); b.st[0] = nloc; b.st[1] = nx; }
        const unsigned old = xb_add(&bar[XB_XSUB(b.x)], 1u);
        const unsigned gen = old / nloc;
        if (old + 1u == (gen + 1u) * nloc) {
            __builtin_amdgcn_fence(__ATOMIC_RELEASE, "agent");
            asm volatile("s_waitcnt vmcnt(0)" ::: "memory");
            const unsigned og = xb_add(&bar[XB_TOP], 1u);
            const unsigned tg = og / nx;
            if (og + 1u == (tg + 1u) * nx) xb_add(&bar[XB_TOPGEN], 1u);
            else XB_SPIN(xb_ld(&bar[XB_TOPGEN]) == tg, bar);
            __builtin_amdgcn_fence(__ATOMIC_ACQUIRE, "agent");
            xb_add(&bar[XB_XGEN(b.x)], 1u);
            asm volatile("s_waitcnt vmcnt(0)" ::: "memory");
        } else {
            XB_SPIN(xb_ld(&bar[XB_XGEN(b.x)]) == gen, bar);
            __builtin_amdgcn_fence(__ATOMIC_ACQUIRE, "agent");
            asm volatile("s_waitcnt vmcnt(0)" ::: "memory");
        }
    }
    __syncthreads();
}

__device__ __forceinline__ int mixa_row(int L0) { const int w = L0 >> 10, ch = L0 & 1023; return w == 0 ? 2048 + ch : 256 * (ch >> 7) + 128 * (w - 1) + (ch & 127); }
__device__ __forceinline__ int map_row(int kind, int n) { const int n0 = n & ~31; return (kind == 0 ? n0 : kind == 2 ? ffnup_row(n0) : kind == 3 ? mixa_row(n0) : headperm_row(n0)) + (n & 31); }
__device__ __forceinline__ void tr_item128(const float* W, int ldw, int k0, int n0, const float* gain, bf16* WT, int Kd, int kind, int noff, LAS float* scr, int lane) {
    const int cl = 4 * (lane & 31), kh = lane >> 5;
    f32x4 v[16];
#pragma unroll
    for (int i = 0; i < 16; ++i) v[i] = *(const f32x4*)(W + (size_t)(k0 + 2 * i + kh) * ldw + n0 + cl);
#pragma unroll
    for (int i = 0; i < 16; ++i) { f32x4 t = v[i]; if (gain) t = t * gain[k0 + 2 * i + kh]; *(LAS f32x4*)(scr + (2 * i + kh) * 132 + cl) = t; }
    LDS_WAIT(); asm volatile("" ::: "memory");
    const int c = lane & 3;
#pragma unroll
    for (int j = 0; j < 8; ++j) { const int n = (lane >> 2) + 16 * j; const LAS float* s = scr + (8 * c) * 132 + n;
        v4u o; o.x = pk2(s[0 * 132], s[1 * 132]); o.y = pk2(s[2 * 132], s[3 * 132]); o.z = pk2(s[4 * 132], s[5 * 132]); o.w = pk2(s[6 * 132], s[7 * 132]);
        *(v4u*)(WT + (size_t)map_row(kind, noff + n0 + n) * Kd + k0 + 8 * c) = o; }
    LDS_WAIT(); asm volatile("" ::: "memory");
}

struct Args { const float* in[16]; float* out; unsigned char* ws; int ph_lo, ph_hi; };

__global__ void __launch_bounds__(NTHREADS, 2) yoco_fwd(Args args) {
    extern __shared__ __attribute__((aligned(16))) unsigned char lds[];
    cg::grid_group grid = cg::this_grid();
    LAS unsigned char* ldsl = (LAS unsigned char*)lds;
    const int tid0 = threadIdx.x, wave = __builtin_amdgcn_readfirstlane(tid0 >> 6);
    const int G = gridDim.x, bx = blockIdx.x, vcu = (G % 8 == 0) ? (bx % 8) * (G / 8) + bx / 8 : bx;
    const int gw = vcu * NWAVES + wave, NGW = G * NWAVES;
    typedef __attribute__((address_space(4))) const unsigned char* kptr_t;
    const kptr_t kargs = (kptr_t)__builtin_amdgcn_kernarg_segment_ptr();
#define ARG_IN(i) (*(const float* const volatile __attribute__((address_space(4)))*)(kargs + 8 * (i)))
#define ARG_OUT (*(float* const volatile __attribute__((address_space(4)))*)(kargs + 128))
#define ARG_WS (*(unsigned char* const volatile __attribute__((address_space(4)))*)(kargs + 136))
#define x_in ARG_IN(0)
#define attn_norm ARG_IN(1)
#define ffn_norm ARG_IN(2)
#define a_w_in ARG_IN(3)
#define a_conv ARG_IN(4)
#define a_w_out ARG_IN(5)
#define kv_norm ARG_IN(6)
#define w_kvf ARG_IN(7)
#define b_f ARG_IN(8)
#define k_norm ARG_IN(9)
#define b_w_qg ARG_IN(10)
#define q_norm ARG_IN(11)
#define b_w_out ARG_IN(12)
#define ffn_w_up ARG_IN(13)
#define ffn_conv ARG_IN(14)
#define ffn_w_down ARG_IN(15)
#define PTRS() int tid; asm volatile("v_mbcnt_lo_u32_b32 %0, -1, 0\n\tv_mbcnt_hi_u32_b32 %0, -1, %0" : "=v"(tid)); tid += wave * 64; const int lane = tid & 63; (void)lane; unsigned char* const ws = ARG_WS; float* const X = ARG_OUT; float* const SSQ = (float*)(ws + WS_CT); \
    bf16* const WF = (bf16*)(ws + WS_WF); bf16* const XB = (bf16*)(ws + WS_XB); bf16* const KB = (bf16*)(ws + WS_K); bf16* const VB = (bf16*)(ws + WS_V); bf16* const GB = KB; \
    bf16* const QO = (bf16*)(ws + WS_ACT); bf16* const SG = (bf16*)(ws + WS_SG); bf16* const HB = (bf16*)(ws + WS_ACT); bf16* const PROJ = (bf16*)(ws + WS_ACT); \
    float* const EDGEA = (float*)(ws + WS_EDGEA); float* const EDGEG = (float*)(ws + WS_EDGEG); float* const FLT = (float*)(ws + WS_FLT); float* const CT = (float*)(ws + WS_CT); \
    (void)X; (void)SSQ; (void)WF; (void)XB; (void)KB; (void)VB; (void)GB; (void)QO; (void)SG; (void)HB; (void)PROJ; (void)EDGEA; (void)EDGEG; (void)FLT; (void)CT;
    const int lo = args.ph_lo, hi = args.ph_hi; int ph = 0;
#define ON() (lo <= ph && ph < hi)
    volatile LAS unsigned* const bst = (volatile LAS unsigned*)(ldsl + LDS_BARST);
    if (tid0 < 2) bst[tid0] = 0u;
    __syncthreads();
#define SEAM() do { if (lo <= ph && ph + 1 < hi) { if (ph == 0) { grid.sync(); (void)xcd_barrier_post((unsigned*)(ARG_WS + WS_CTL), bst); } else { XcdBarrier xb_; xb_.bar = (unsigned*)(ARG_WS + WS_CTL); xb_.x = xb_xcc_id(); xb_.st = bst; xcd_barrier(xb_); } } ++ph; } while (0)

    if (ON()) { PTRS();
        if (bx == 0) for (int i = tid; i < (int)(CTL_BYTES / 4); i += NTHREADS) ((unsigned*)(ws + WS_CTL))[i] = 0u;
#pragma nounroll
      for (int rp = 0; rp < ((PROBE_X & 16) ? 2 : 1); ++rp) {
        LAS float* scr = (LAS float*)(ldsl + wave * 16896);
        constexpr int NITEMS = 2 * 768 + 2 * 256 + 512 + 512 + 16 + 512 + 2 * 256 + 4 * 1408 + 4 * 704;
        for (int it = gw; it < NITEMS; it += NGW) {
            int r = it;
            if (r < 1536) { const int l = r / 768; r %= 768; const int kb = r / 24, nb = r % 24;
                tr_item128(a_w_in + (size_t)l * D * 3 * D, 3 * D, 32 * kb, 128 * nb, attn_norm + l * D, (bf16*)(ws + WS_WIN) + (size_t)l * 3 * D * D, D, 3, 0, scr, lane); continue; } r -= 1536;
            if (r < 512) { const int l = r / 256; r %= 256; const int kb = r / 8, nb = r % 8;
                tr_item128(a_w_out + (size_t)l * D * D, D, 32 * kb, 128 * nb, nullptr, (bf16*)(ws + WS_WOUT) + (size_t)l * D * D, D, 0, 0, scr, lane); continue; } r -= 512;
            if (r < 512) { const int kb = r / 16, nb = r % 16;
                tr_item128(b_w_qg, 2 * D, 32 * kb, 128 * nb, attn_norm + 2 * D, (bf16*)(ws + WS_WQGKV), D, 1, 0, scr, lane); continue; } r -= 512;
            if (r < 512) { const int kb = r / 16, nb = r % 16;
                tr_item128(w_kvf, 2 * D + H, 32 * kb, 128 * nb, kv_norm, (bf16*)(ws + WS_WQGKV), D, 1, 2048, scr, lane); continue; } r -= 512;
            if (r < 16) { tr_item(w_kvf, 2 * D + H, 64 * r, 2 * D, kv_norm, WF, D, 0, 16, scr, lane); continue; } r -= 16;
            if (r < 512) { const int kb = r / 16, nb = r % 16;
                tr_item128(b_w_qg + (size_t)D * 2 * D, 2 * D, 32 * kb, 128 * nb, attn_norm + 3 * D, (bf16*)(ws + WS_WQG3), D, 1, 0, scr, lane); continue; } r -= 512;
            if (r < 512) { const int l = r / 256; r %= 256; const int kb = r / 8, nb = r % 8;
                tr_item128(b_w_out + (size_t)l * D * D, D, 32 * kb, 128 * nb, nullptr, (bf16*)(ws + WS_WBO) + (size_t)l * D * D, D, 0, 0, scr, lane); continue; } r -= 512;
            if (r < 4 * 1408) { const int l = r / 1408; r %= 1408; const int kb = r / 44, nb = r % 44;
                tr_item128(ffn_w_up + (size_t)l * D * 2 * FF, 2 * FF, 32 * kb, 128 * nb, ffn_norm + l * D, (bf16*)(ws + WS_WUP) + (size_t)l * 2 * FF * D, D, 2, 0, scr, lane); continue; } r -= 4 * 1408;
            { const int l = r / 704; r %= 704; const int kb = r / 8, nb = r % 8;
                tr_item128(ffn_w_down + (size_t)l * FF * D, D, 32 * kb, 128 * nb, nullptr, (bf16*)(ws + WS_WDN) + (size_t)l * D * FF, FF, 0, 0, scr, lane); }
        }
        for (int m = gw; m < M; m += NGW) {
            const f32x4* xr = (const f32x4*)(x_in + (size_t)m * D) + lane; f32x4 v[4]; float s = 0.f;
#pragma unroll
            for (int j = 0; j < 4; ++j) { v[j] = xr[64 * j]; s += (v[j].x * v[j].x + v[j].y * v[j].y) + (v[j].z * v[j].z + v[j].w * v[j].w); }
            s = wave_sum(s);
            v2u* o8 = (v2u*)(XB + (size_t)m * D) + lane;
#pragma unroll
            for (int j = 0; j < 4; ++j) { v2u o; o.x = pk2(v[j].x, v[j].y); o.y = pk2(v[j].z, v[j].w); o8[64 * j] = o; }
            if (lane < 4) SSQ[(size_t)m * 4 + lane] = lane == 0 ? s : 0.f;
        }
      }
    }
    SEAM();

#pragma nounroll
    for (int l = 0; l < 4; ++l) {
#pragma nounroll
        for (int half = 0; half < 2; ++half) {
            if (half == 0) {
                if (l < 2) {
                    if (ON()) { PTRS(); const float* ssq_in = SSQ; pg8::Gemm g{XB, (const bf16*)(ws + WS_WIN) + (size_t)l * 3 * D * D, M, 3 * D, D}; pg8::StaticOrder S; S.init(M, 3 * D, G, bx, (PROBE_X & 4) ? 2 : 1);
                        pg8::EpiMixA E{PROJ, PROJ + (size_t)M * D, ssq_in};
                        pg8::gemm_phase<pg8::EpiMixA, pg8::StaticOrder, true, true>(ldsl, g, S, E, tid); }
                    SEAM();
                    if (ON()) { PTRS();
                        const float* cw = a_conv + (size_t)l * 3 * D; const bf16* Bo = PROJ; const bf16* CHp = PROJ + (size_t)M * D;
                        for (int item = vcu * NTHREADS + tid; item < (M / 32) * 128; item += G * NTHREADS) {
                            const int cgp = item & 127, r0 = (item >> 7) * 32, c0 = 8 * cgp;
                            float w0[8], w1[8], w2[8], p1[8], p2[8];
#pragma unroll
                            for (int e = 0; e < 8; ++e) { w0[e] = cw[c0 + e]; w1[e] = cw[D + c0 + e]; w2[e] = cw[2 * D + c0 + e]; p1[e] = 0.f; p2[e] = 0.f; }
                            if ((r0 & (T - 1)) != 0) {
                                const v4u c2 = *(const v4u*)(CHp + (size_t)(r0 - 2) * D + c0), c1 = *(const v4u*)(CHp + (size_t)(r0 - 1) * D + c0);
#pragma unroll
                                for (int k = 0; k < 4; ++k) { p2[2 * k] = bflo(c2[k]); p2[2 * k + 1] = bfhi(c2[k]); p1[2 * k] = bflo(c1[k]); p1[2 * k + 1] = bfhi(c1[k]); }
                            }
#pragma nounroll
                            for (int r = r0; r < r0 + 32; r += 4) {
                                v4u bb[4], cc[4];
#pragma unroll
                                for (int i = 0; i < 4; ++i) { bb[i] = *(const v4u*)(Bo + (size_t)(r + i) * D + c0); cc[i] = *(const v4u*)(CHp + (size_t)(r + i) * D + c0); }
#pragma unroll
                                for (int i = 0; i < 4; ++i) {
                                    float ch[8], o[8];
#pragma unroll
                                    for (int k = 0; k < 4; ++k) { ch[2 * k] = bflo(cc[i][k]); ch[2 * k + 1] = bfhi(cc[i][k]); }
#pragma unroll
                                    for (int e = 0; e < 8; ++e) { const float u = w0[e] * p2[e] + w1[e] * p1[e] + w2[e] * ch[e]; p2[e] = p1[e]; p1[e] = ch[e]; o[e] = u; }
                                    v4u ov;
#pragma unroll
                                    for (int k = 0; k < 4; ++k) ov[k] = pk2(bflo(bb[i][k]) * o[2 * k], bfhi(bb[i][k]) * o[2 * k + 1]);
                                    *(v4u*)(GB + (size_t)(r + i) * D + c0) = ov;
                                }
                            }
                        }
                    }
                    SEAM();
                } else {
                    if (ON()) { PTRS(); const float* ssq_in = SSQ;
                        const int j = l - 2, N = (l == 2) ? 4 * D : 2 * D;
                        pg8::Gemm g{XB, (const bf16*)(ws + (l == 2 ? WS_WQGKV : WS_WQG3)), M, N, D}; pg8::StaticOrder S; S.init(M, N, G, bx, (PROBE_X & 4) ? 2 : 1);
                        pg8::EpiQG E{QO, SG, KB, VB, ssq_in, q_norm + j * HD, k_norm, attn_body::C2};
                        pg8::gemm_phase<pg8::EpiQG, pg8::StaticOrder, true, true>(ldsl, g, S, E, tid);
                        if (l == 2) {
                            for (int rg = gw; rg < M / 16; rg += NGW) {
                                f32x4 acc = (f32x4){0.f, 0.f, 0.f, 0.f};
                                const bf16* wp = WF + (size_t)(lane & 15) * D + 8 * (lane >> 4); const bf16* xp = XB + (size_t)(16 * rg + (lane & 15)) * D + 8 * (lane >> 4);
#pragma unroll 8
                                for (int kt = 0; kt < 32; ++kt) { const bf16x8 wa = *(const bf16x8*)(wp + 32 * kt), xa = *(const bf16x8*)(xp + 32 * kt); acc = __builtin_amdgcn_mfma_f32_16x16x32_bf16(wa, xa, acc, 0, 0, 0); }
                                const int row = 16 * rg + (lane & 15), bb = row / T, s = row % T; const float rs = pg8::rstd_of(ssq_in, row);
#pragma unroll
                                for (int e = 0; e < 4; ++e) { const int hd = 4 * (lane >> 4) + e; const float z = acc[e] * rs + b_f[hd];
                                    const float ls = fminf(z, 0.f) - log1pf(expf(-fabsf(z))); FLT[(size_t)(bb * H + hd) * T + s] = ls; }
                            }
                        }
                    }
                    SEAM();
                    if (l == 2) {
                        if (ON()) { PTRS();
                            for (int bh = vcu; bh < BATCH * H; bh += G) {
                                const f32x4* src = (const f32x4*)(FLT + (size_t)bh * T + 16 * tid); f32x4 v[4]; float run = 0.f;
#pragma unroll
                                for (int q = 0; q < 4; ++q) { v[q] = src[q]; v[q].x += run; v[q].y += v[q].x; v[q].z += v[q].y; v[q].w += v[q].z; run = v[q].w; }
                                float inc = run;
#pragma unroll
                                for (int o = 1; o < 64; o <<= 1) { const float t = __shfl_up(inc, o); if (lane >= o) inc += t; }
                                LAS float* wsum = (LAS float*)ldsl;
                                __syncthreads();
                                if (lane == 63) wsum[wave] = inc;
                                __syncthreads();
                                float off = inc - run;
                                for (int w = 0; w < wave; ++w) off += wsum[w];
                                LAS float* cl = (LAS float*)(ldsl + 1024);
                                v2u* kxg = (v2u*)(X) + (size_t)bh * T + 16 * tid;
#pragma unroll
                                for (int q = 0; q < 4; ++q) { const f32x4 c4 = (v[q] + off) * 1.4426950408889634f; *(LAS f32x4*)(cl + 16 * tid + 4 * q) = c4;
#pragma unroll
                                    for (int e = 0; e < 4; ++e) { const float bb = -c4[e]; const unsigned h_ = f2bf(bb); const float r1 = bb - __builtin_bit_cast(float, h_ << 16);
                                        const unsigned m_ = f2bf(r1); const float r2 = r1 - __builtin_bit_cast(float, m_ << 16); v2u w; w.x = h_ | (m_ << 16); w.y = f2bf(r2) | 0x3f800000u; kxg[4 * q + e] = w; } }
                                __syncthreads();
                                float gk = fabsf(k_norm[lane]), gq0 = fabsf(q_norm[lane]), gq1 = fabsf(q_norm[HD + lane]);
#pragma unroll
                                for (int o = 1; o < 64; o <<= 1) { gk = fmaxf(gk, __shfl_xor(gk, o)); gq0 = fmaxf(gq0, __shfl_xor(gq0, o)); gq1 = fmaxf(gq1, __shfl_xor(gq1, o)); }
                                const int qb = tid >> 4, jj = tid & 15, NT0 = 4 * qb + 4; const float cq = cl[256 * qb];
#pragma unroll
                                for (int ly = 0; ly < 2; ++ly) {
                                    const float TH = 2.0f * (8.0f * (ly == 0 ? gq0 : gq1) * gk * 1.4426950408889634f * 1.05f) + 160.0f;
                                    int j0 = NT0 - 4;
                                    for (int j = jj; j < NT0; j += 16) if (cq - cl[64 * j + 63] >= -TH) { j0 = min(j0, j); break; }
#pragma unroll
                                    for (int o = 1; o < 16; o <<= 1) j0 = min(j0, __shfl_xor(j0, o));
                                    if (jj == 0) ((unsigned*)(X + 2 * 1024 * 1024))[(ly * BATCH * H + bh) * 32 + qb] = (unsigned)(j0 & ~1);
                                }
                                __syncthreads();
                            }
                        }
                        SEAM();
                    }
                    if (ON()) { PTRS();
                        float gq = fabsf(q_norm[(l - 2) * HD + lane]), gk = fabsf(k_norm[lane]);
#pragma unroll
                        for (int o = 1; o < 64; o <<= 1) { gq = fmaxf(gq, __shfl_xor(gq, o)); gk = fmaxf(gk, __shfl_xor(gk, o)); }
                        const float BND = 8.0f * gq * gk * 1.4426950408889634f * 1.05f;
#pragma nounroll
                        for (int rp = 0; rp < ((PROBE_X & 2) ? 2 : 1); ++rp) {
                            const attn_body::AttnTensors AT{(const attn_body::bf16*)QO, (const attn_body::bf16*)KB, (const attn_body::bf16*)VB, (attn_body::bf16*)(((PROBE_X & 2) && rp == 0) ? ws + WS_ACT + 128 * MiB : ws + WS_ACT), (const attn_body::bf16*)SG, (const unsigned*)X, (const unsigned*)(X + 2 * 1024 * 1024) + (l - 2) * BATCH * H * 32};
                            unsigned* const qctr = (unsigned*)(ws + WS_CTL) + 3584 + 64 * (l - 2) + 128 * rp;
                            attn_body::attn_phase<40>((char*)lds, AT, qctr, BND, tid, (PROBE_X & 32) && rp == 0); __syncthreads(); }
                    }
                    SEAM();
                }
            } else {
                if (ON()) { PTRS(); const float* ssq_in = SSQ; pg8::Gemm g{XB, (const bf16*)(ws + WS_WUP) + (size_t)l * 2 * FF * D, M, 2 * FF, D}; pg8::StaticOrder S; S.init(M, 2 * FF, G, bx, (PROBE_X & 1) ? 2 : 1);
                    pg8::EpiFfnUp E{HB, ssq_in, ffn_conv + (size_t)l * 3 * FF, EDGEA, EDGEG};
pg8::gemm_phase<pg8::EpiFfnUp, pg8::StaticOrder, true, true>(ldsl, g, S, E, tid); }
                SEAM();
            }
            if (ON()) { PTRS(); float* ssq_out = SSQ;
                const bf16* A = half == 1 ? HB : (l < 2 ? GB : QO);
                const bf16* Bt = half == 1 ? (const bf16*)(ws + WS_WDN) + (size_t)l * D * FF : (l < 2 ? (const bf16*)(ws + WS_WOUT) + (size_t)l * D * D : (const bf16*)(ws + WS_WBO) + (size_t)(l - 2) * D * D);
                pg8::Gemm g{A, Bt, M, D, half == 1 ? FF : D}; pg8::StaticOrder S; S.init(M, D, G, bx, (PROBE_X & 8) ? 2 : 1);
                if (half == 1) {
                    const float* cw = ffn_conv + (size_t)l * 3 * FF; pg8::Unit uu;
                    for (int ui = 0; S.next(ui, uu); ++ui) {
                        for (int it0 = tid; it0 < 4 * (FF / 4); it0 += 3 * NTHREADS) {
                            f32x4 a0[3], a1[3], pm2[3], pm1[3], g0[3], g1[3], w0[3], w1[3], w2[3]; int grpv[3], chv[3]; bool okv[3];
#pragma unroll
                            for (int k = 0; k < 3; ++k) {
                                const int itk = it0 + k * NTHREADS; okv[k] = itk < 4 * (FF / 4); const int item = okv[k] ? itk : it0;
                                const int grp = 4 * uu.pm + item / (FF / 4), ch = 4 * (item % (FF / 4)); const bool first = ((grp * 64) & (T - 1)) == 0; grpv[k] = grp; chv[k] = ch;
                                const f32x4 z4 = (f32x4){0.f, 0.f, 0.f, 0.f};
                                a0[k] = *(const f32x4*)(EDGEA + ((size_t)grp * 4 + 0) * FF + ch); a1[k] = *(const f32x4*)(EDGEA + ((size_t)grp * 4 + 1) * FF + ch);
                                pm2[k] = first ? z4 : *(const f32x4*)(EDGEA + ((size_t)(grp - 1) * 4 + 2) * FF + ch); pm1[k] = first ? z4 : *(const f32x4*)(EDGEA + ((size_t)(grp - 1) * 4 + 3) * FF + ch);
                                g0[k] = *(const f32x4*)(EDGEG + ((size_t)grp * 2 + 0) * FF + ch); g1[k] = *(const f32x4*)(EDGEG + ((size_t)grp * 2 + 1) * FF + ch);
                                w0[k] = *(const f32x4*)(cw + ch); w1[k] = *(const f32x4*)(cw + FF + ch); w2[k] = *(const f32x4*)(cw + 2 * FF + ch);
                            }
#pragma unroll
                            for (int k = 0; k < 3; ++k) {
                                const f32x4 c0 = w0[k] * pm2[k] + w1[k] * pm1[k] + w2[k] * a0[k], c1 = w0[k] * pm1[k] + w1[k] * a0[k] + w2[k] * a1[k]; f32x4 h0, h1;
#pragma unroll
                                for (int e = 0; e < 4; ++e) { h0[e] = c0[e] * pg8::sigmoidf_fast(c0[e]) * g0[k][e]; h1[e] = c1[e] * pg8::sigmoidf_fast(c1[e]) * g1[k][e]; }
                                v2u o0, o1; o0.x = pk2(h0[0], h0[1]); o0.y = pk2(h0[2], h0[3]); o1.x = pk2(h1[0], h1[1]); o1.y = pk2(h1[2], h1[3]);
                                if (okv[k]) { *(v2u*)(HB + (size_t)(grpv[k] * 64) * FF + chv[k]) = o0; *(v2u*)(HB + (size_t)(grpv[k] * 64 + 1) * FF + chv[k]) = o1; }
                            }
                        }
                    }
                    asm volatile("s_waitcnt vmcnt(0)" ::: "memory"); __syncthreads();
                }
pg8::EpiRes E{(l == 0 && half == 0) ? x_in : (const float*)nullptr, (l == 3 && half == 1) ? X : (float*)nullptr, XB, ssq_out, (LAS float*)(ldsl + RING_BYTES), (PROBE_X & 8) ? 2 : 1};
                pg8::gemm_phase<pg8::EpiRes, pg8::StaticOrder, true, true>(ldsl, g, S, E, tid);
            }
            SEAM();
        }
    }
#undef ON
#undef SEAM
#undef PTRS
#undef x_in
#undef attn_norm
#undef ffn_norm
#undef a_w_in
#undef a_conv
#undef a_w_out
#undef kv_norm
#undef w_kvf
#undef b_f
#undef k_norm
#undef b_w_qg
#undef q_norm
#undef b_w_out
#undef ffn_w_up
#undef ffn_conv
#undef ffn_w_down
}

extern "C" void kernel_launch(void* const* d_in, const int* in_sizes, int n_in, void* d_out, int out_size, void* d_ws, size_t ws_size, hipStream_t stream) {
    static int grid = 0;
    if (grid == 0) {
        if (n_in != 16 || in_sizes[0] != M * D || out_size != M * D || ws_size < WS_END) { fprintf(stderr, "kernel_launch: unexpected shapes: n_in %d in0 %d out %d ws %zu (need %zu)\n", n_in, n_in > 0 ? in_sizes[0] : -1, out_size, ws_size, (size_t)WS_END); grid = -1; return; }
        int dev = 0, cus = 0, per_cu = 0;
        if (hipGetDevice(&dev) != hipSuccess || hipDeviceGetAttribute(&cus, hipDeviceAttributeMultiprocessorCount, dev) != hipSuccess) { grid = -1; return; }
        if (hipFuncSetAttribute((const void*)yoco_fwd, hipFuncAttributeMaxDynamicSharedMemorySize, LDS_BYTES) != hipSuccess) { fprintf(stderr, "kernel_launch: hipFuncSetAttribute failed\n"); grid = -1; return; }
        if (hipOccupancyMaxActiveBlocksPerMultiprocessor(&per_cu, (const void*)yoco_fwd, NTHREADS, LDS_BYTES) != hipSuccess || per_cu < 1) { fprintf(stderr, "kernel_launch: occupancy query says %d blocks per CU\n", per_cu); per_cu = 1; }
        (void)hipGetLastError();
        grid = cus * per_cu;
        fprintf(stderr, "kernel_launch: grid %d (%d CUs x %d)\n", grid, cus, per_cu);
    }
    if (grid < 0) return;
#if MK_MULTI
    if (hipMemsetAsync((char*)d_ws + WS_CTL, 0, CTL_BYTES, stream) != hipSuccess) { fprintf(stderr, "kernel_launch: memset failed\n"); return; }
#endif
    Args a{};
    for (int i = 0; i < 16; ++i) a.in[i] = (const float*)d_in[i];
    a.out = (float*)d_out; a.ws = (unsigned char*)d_ws;
#if MK_MULTI
    for (int p = 0; p < N_PHASES; ++p) { a.ph_lo = p; a.ph_hi = p + 1; hipLaunchKernelGGL(yoco_fwd, dim3(grid), dim3(NTHREADS), LDS_BYTES, stream, a); }
#else
    a.ph_lo = 0; a.ph_hi = N_PHASES;
    void* kargs[] = {&a};
    const hipError_t e = hipLaunchCooperativeKernel((const void*)yoco_fwd, dim3(grid), dim3(NTHREADS), kargs, LDS_BYTES, stream);
    if (e != hipSuccess) fprintf(stderr, "kernel_launch: cooperative launch failed: %s (grid %d)\n", hipGetErrorString(e), grid);
#endif
}
```

```cpp
#include <hip/hip_runtime.h>
#include <cstdio>
#include <cstdint>
#include <hip/hip_cooperative_groups.h>
namespace pg8 {
#define PG8_LAS __attribute__((address_space(3)))
typedef unsigned short bf16_t;
typedef short bf16x8 __attribute__((ext_vector_type(8)));
typedef float f32x4 __attribute__((ext_vector_type(4)));
typedef unsigned u32x4 __attribute__((ext_vector_type(4)));
constexpr int BM = 256, BK = 64, HALF = 128, HTB = HALF * BK * 2  , STAGE_BYTES = 8 * HTB, NXCD = 8, WGM = 4;

__host__ __device__ __forceinline__ int lds_byte(int r, int c) { const int st = (r >> 4) * 2 + (c >> 5), rr = r & 15, cc = c & 31, ob = rr * 64 + cc * 2; return st * 1024 + (ob ^ (((ob >> 9) & 1) << 5)); }
__host__ __device__ __forceinline__ void stage_rc(int b, int& R, int& C) { const int st = b / 1024, sb = b % 1024, swz = sb ^ (((sb >> 9) & 1) << 5); R = (st >> 1) * 16 + swz / 64; C = (st & 1) * 32 + (swz % 64) / 2; }
__host__ __device__ __forceinline__ int perm32(int rho) { const int n = rho >> 4, i = rho & 15; return 8 * (i >> 2) + 4 * n + (i & 3); }

struct Unit { int pm, pn, rp; };
struct Gemm { const bf16_t* A; const bf16_t* Bt; int M, N, K; };

struct StaticOrder {
    int nM, nN, nwg, G, c, rep;
    __host__ __device__ void init(int M, int N, int G_, int c_, int rep_ = 1) { nM = M / BM; nN = N / BM; nwg = nM * nN; G = G_; c = c_; rep = rep_; }
    __host__ __device__ bool next(int i, Unit& u) const {
        const long L = (long)(i / rep) * G + c; if (L >= nwg) return false;
        int wgid = (int)L; { const int q = nwg / NXCD, r = nwg % NXCD, xcd = wgid % NXCD, off = wgid / NXCD; wgid = (xcd < r ? xcd * (q + 1) : r * (q + 1) + (xcd - r) * q) + off; }
        const int nig = WGM * nN, gid = wgid / nig, fm = gid * WGM, gsz = (nM - fm) < WGM ? (nM - fm) : WGM;
        u.pm = fm + ((wgid % nig) % gsz); u.pn = (wgid % nig) / gsz; u.rp = i % rep; return true;
    }
    __device__ __forceinline__ void a_ready(const Unit&) const {}
    __device__ __forceinline__ void done(const Unit&) const {}
};

__device__ __forceinline__ unsigned cvt_pk_bf16(float lo, float hi) { unsigned r; asm volatile("v_cvt_pk_bf16_f32 %0, %1, %2" : "=v"(r) : "v"(lo), "v"(hi)); return r; }
typedef float f32x2 __attribute__((ext_vector_type(2)));
__device__ __forceinline__ f32x2 gelu_pk(f32x2 v) {
    const f32x2 av = __builtin_elementwise_abs(v), d = av * 0.2316418882f + 1.0f;
    f32x2 t; t.x = __builtin_amdgcn_rcpf(d.x); t.y = __builtin_amdgcn_rcpf(d.y);
    f32x2 q = t * 0.5307027145f + (-0.7265760135f); q = q * t + 0.7107068705f; q = q * t + (-0.142248368f); q = q * t + 0.127414796f; q = q * t;
    const f32x2 s = (v * v) * (-0.72134752044f);
    f32x2 e; e.x = __builtin_amdgcn_exp2f(s.x); e.y = __builtin_amdgcn_exp2f(s.y);
    const f32x2 m = v * (q * e), r = v - m;
    f32x2 o; o.x = v.x < 0.f ? m.x : r.x; o.y = v.y < 0.f ? m.y : r.y; return o;
}

template <int ACT  > struct EpiBf16 {
    static constexpr bool PERM = true, AFTER_DRAIN = false; static_assert(ACT == 0 || ACT == 1, "EpiBf16: ACT is 0 (none) or 1 (gelu_pk)");
    bf16_t* O; int ldc; const float* bias; int split_cols; size_t split_stride; float scale0;
    __device__ __forceinline__ void operator()(const f32x4 (&acc)[2][2][4][2], const Unit& u, int wr, int wc, int fr_, int fq_) const {
        int fr = fr_, fq = fq_; asm volatile("" : "+v"(fr), "+v"(fq));
        const int row0 = u.pm * BM + wr * 64 + fr; int colt = u.pn * BM; bf16_t* base = O;
        float sc = 1.f; if (split_cols) { const int t = colt / split_cols; base += (size_t)t * split_stride; colt -= t * split_cols; if (t == 0) sc = scale0; }
        const int col0 = colt + wc * 32 + 8 * fq, bcol0 = u.pn * BM + wc * 32 + 8 * fq;
        f32x4 bv[2][2];
#pragma unroll
        for (int bj = 0; bj < 2; ++bj)
#pragma unroll
            for (int n = 0; n < 2; ++n) bv[bj][n] = bias ? *(const f32x4*)(bias + bcol0 + bj * HALF + 4 * n) : (f32x4){0.f, 0.f, 0.f, 0.f};
#pragma unroll
        for (int ai = 0; ai < 2; ++ai)
#pragma unroll
            for (int m = 0; m < 4; ++m) { bf16_t* rowp = base + (size_t)(row0 + ai * HALF + m * 16) * ldc + col0;
#pragma unroll
                for (int bj = 0; bj < 2; ++bj) { f32x4 v0 = acc[ai][bj][m][0] + bv[bj][0], v1 = acc[ai][bj][m][1] + bv[bj][1];
                    if (ACT == 1) { f32x2 a = gelu_pk((f32x2){v0[0], v0[1]}), b = gelu_pk((f32x2){v0[2], v0[3]}), c = gelu_pk((f32x2){v1[0], v1[1]}), d = gelu_pk((f32x2){v1[2], v1[3]});
                        v0 = (f32x4){a.x, a.y, b.x, b.y}; v1 = (f32x4){c.x, c.y, d.x, d.y}; }
                    v0 = v0 * sc; v1 = v1 * sc; u32x4 w; w.x = cvt_pk_bf16(v0[0], v0[1]); w.y = cvt_pk_bf16(v0[2], v0[3]); w.z = cvt_pk_bf16(v1[0], v1[1]); w.w = cvt_pk_bf16(v1[2], v1[3]);
                    *(u32x4*)(rowp + bj * HALF) = w; } }
    }
};
__device__ __forceinline__ float rstd_of(const float* ssq, int row) { const f32x4 a = *(const f32x4*)(ssq + (size_t)row * 4); return __builtin_amdgcn_rsqf(((a[0] + a[1]) + (a[2] + a[3])) * (1.0f / 1024.0f) + 1e-6f); }
__device__ __forceinline__ float ror1f(float v) { return __builtin_bit_cast(float, __builtin_amdgcn_mov_dpp(__builtin_bit_cast(int, v), 0x121, 0xf, 0xf, false)); }
__device__ __forceinline__ float ror2f(float v) { return __builtin_bit_cast(float, __builtin_amdgcn_mov_dpp(__builtin_bit_cast(int, v), 0x122, 0xf, 0xf, false)); }
__device__ __forceinline__ float sigmoidf_fast(float v) { return __builtin_amdgcn_rcpf(1.0f + __builtin_amdgcn_exp2f(v * -1.4426950408889634f)); }

struct EpiScaleBf16 {
    static constexpr bool PERM = true, AFTER_DRAIN = false;
    bf16_t* O; int ldc; const float* ssq;
    __device__ __forceinline__ void operator()(const f32x4 (&acc)[2][2][4][2], const Unit& u, int wr, int wc, int fr_, int fq_) const {
        int fr = fr_, fq = fq_; asm volatile("" : "+v"(fr), "+v"(fq));
        const int row0 = u.pm * BM + wr * 64 + fr, col0 = u.pn * BM + wc * 32 + 8 * fq;
        float rsv[2][4];
#pragma unroll
        for (int ai = 0; ai < 2; ++ai)
#pragma unroll
            for (int m = 0; m < 4; ++m) rsv[ai][m] = rstd_of(ssq, row0 + ai * HALF + m * 16);
#pragma unroll
        for (int ai = 0; ai < 2; ++ai)
#pragma unroll
            for (int m = 0; m < 4; ++m) { const int row = row0 + ai * HALF + m * 16; const float rs = rsv[ai][m]; bf16_t* rowp = O + (size_t)row * ldc + col0;
#pragma unroll
                for (int bj = 0; bj < 2; ++bj) { const f32x4 v0 = acc[ai][bj][m][0] * rs, v1 = acc[ai][bj][m][1] * rs;
                    u32x4 w; w.x = cvt_pk_bf16(v0[0], v0[1]); w.y = cvt_pk_bf16(v0[2], v0[3]); w.z = cvt_pk_bf16(v1[0], v1[1]); w.w = cvt_pk_bf16(v1[2], v1[3]);
                    *(u32x4*)(rowp + bj * HALF) = w; } }
    }
};
struct EpiMixA {
    static constexpr bool PERM = true, AFTER_DRAIN = false;
    bf16_t* Bo; bf16_t* CH; const float* ssq;
    __device__ __forceinline__ void operator()(const f32x4 (&acc)[2][2][4][2], const Unit& u, int wr, int wc, int fr_, int fq_) const {
        int fr = fr_, fq = fq_; asm volatile("" : "+v"(fr), "+v"(fq));
        const int row0 = u.pm * BM + wr * 64 + fr;
        float rsv[2][4];
#pragma unroll
        for (int ai = 0; ai < 2; ++ai)
#pragma unroll
            for (int m = 0; m < 4; ++m) rsv[ai][m] = rstd_of(ssq, row0 + ai * HALF + m * 16);
        if (u.pn < 8) {
            const int col0 = u.pn * 128 + wc * 32 + 8 * fq;
#pragma unroll
            for (int ai = 0; ai < 2; ++ai)
#pragma unroll
                for (int m = 0; m < 4; ++m) { const float rs2 = rsv[ai][m] * rsv[ai][m]; const f32x4 v0 = acc[ai][0][m][0] * acc[ai][1][m][0] * rs2, v1 = acc[ai][0][m][1] * acc[ai][1][m][1] * rs2;
                    u32x4 w; w.x = cvt_pk_bf16(v0[0], v0[1]); w.y = cvt_pk_bf16(v0[2], v0[3]); w.z = cvt_pk_bf16(v1[0], v1[1]); w.w = cvt_pk_bf16(v1[2], v1[3]);
                    *(u32x4*)(CH + (size_t)(row0 + ai * HALF + m * 16) * 1024 + col0) = w; }
        } else {
            const int col0 = (u.pn - 8) * BM + wc * 32 + 8 * fq;
#pragma unroll
            for (int ai = 0; ai < 2; ++ai)
#pragma unroll
                for (int m = 0; m < 4; ++m) { const float rs = rsv[ai][m]; bf16_t* rowp = Bo + (size_t)(row0 + ai * HALF + m * 16) * 1024 + col0;
#pragma unroll
                    for (int bj = 0; bj < 2; ++bj) { const f32x4 v0 = acc[ai][bj][m][0] * rs, v1 = acc[ai][bj][m][1] * rs;
                        u32x4 w; w.x = cvt_pk_bf16(v0[0], v0[1]); w.y = cvt_pk_bf16(v0[2], v0[3]); w.z = cvt_pk_bf16(v1[0], v1[1]); w.w = cvt_pk_bf16(v1[2], v1[3]);
                        *(u32x4*)(rowp + bj * HALF) = w; } }
        }
    }
};
struct EpiRes {
    static constexpr bool PERM = true, AFTER_DRAIN = false;
    const float* xin32; float* xout32; bf16_t* xb; float* ssq_out; PG8_LAS float* sq_lds; int nrep;
    __device__ __forceinline__ void operator()(const f32x4 (&acc)[2][2][4][2], const Unit& u, int wr, int wc, int fr_, int fq_) const {
        int fr = fr_, fq = fq_; asm volatile("" : "+v"(fr), "+v"(fq));
        const int row0 = u.pm * BM + wr * 64 + fr, col0 = u.pn * BM + wc * 32 + 8 * fq;
#pragma unroll
        for (int ai = 0; ai < 2; ++ai) {
            u32x4 xo[4][2];
            if (!(xin32 && u.rp == 0)) {
#pragma unroll
                for (int m = 0; m < 4; ++m)
#pragma unroll
                    for (int bj = 0; bj < 2; ++bj) xo[m][bj] = *(const u32x4*)(xb + (size_t)(row0 + ai * HALF + m * 16) * 1024 + col0 + bj * HALF);
            }
#pragma unroll
            for (int m = 0; m < 4; ++m) { const int row = row0 + ai * HALF + m * 16; const size_t off = (size_t)row * 1024 + col0; float s = 0.f;
#pragma unroll
                for (int bj = 0; bj < 2; ++bj) {
                    f32x4 x0, x1;
                    if (xin32 && u.rp == 0) { x0 = *(const f32x4*)(xin32 + off + bj * HALF); x1 = *(const f32x4*)(xin32 + off + bj * HALF + 4); }
                    else { const u32x4 o = xo[m][bj];
                        x0 = (f32x4){__builtin_bit_cast(float, o.x << 16), __builtin_bit_cast(float, o.x & 0xffff0000u), __builtin_bit_cast(float, o.y << 16), __builtin_bit_cast(float, o.y & 0xffff0000u)};
                        x1 = (f32x4){__builtin_bit_cast(float, o.z << 16), __builtin_bit_cast(float, o.z & 0xffff0000u), __builtin_bit_cast(float, o.w << 16), __builtin_bit_cast(float, o.w & 0xffff0000u)}; }
                    const float sc = nrep > 1 ? 1.0f / (float)nrep : 1.0f; const f32x4 v0 = x0 + acc[ai][bj][m][0] * sc, v1 = x1 + acc[ai][bj][m][1] * sc;
                    if (xout32) { *(f32x4*)(xout32 + off + bj * HALF) = v0; *(f32x4*)(xout32 + off + bj * HALF + 4) = v1; }
                    s += (v0[0] * v0[0] + v0[1] * v0[1]) + (v0[2] * v0[2] + v0[3] * v0[3]) + (v1[0] * v1[0] + v1[1] * v1[1]) + (v1[2] * v1[2] + v1[3] * v1[3]);
                    u32x4 w; w.x = cvt_pk_bf16(v0[0], v0[1]); w.y = cvt_pk_bf16(v0[2], v0[3]); w.z = cvt_pk_bf16(v1[0], v1[1]); w.w = cvt_pk_bf16(v1[2], v1[3]);
                    if (!xout32) *(u32x4*)(xb + off + bj * HALF) = w; }
                s += __shfl_xor(s, 16); s += __shfl_xor(s, 32);
                if (fq == 0) sq_lds[(ai * HALF + wr * 64 + m * 16 + fr) * 4 + wc] = s; }
        }
        asm volatile("s_waitcnt lgkmcnt(0)" ::: "memory"); __builtin_amdgcn_s_barrier(); asm volatile("" ::: "memory");
        const int t = (wr * 4 + wc) * 64 + fq * 16 + fr;
        if (t < 256 && u.rp == nrep - 1 && !xout32) { const f32x4 p4 = *(const PG8_LAS f32x4*)(sq_lds + t * 4); ssq_out[(size_t)(u.pm * BM + t) * 4 + u.pn] = (p4[0] + p4[1]) + (p4[2] + p4[3]); }
    }
};
struct EpiQG {
    static constexpr bool PERM = true, AFTER_DRAIN = false;
    bf16_t *Q, *SG, *Kb, *Vb; const float* ssq; const float* qn; const float* kn; float qscale;
    __device__ __forceinline__ void operator()(const f32x4 (&acc)[2][2][4][2], const Unit& u, int wr, int wc, int fr_, int fq_) const {
        int fr = fr_, fq = fq_; asm volatile("" : "+v"(fr), "+v"(fq));
        const int kind = u.pn >> 2;
        const int row0 = u.pm * BM + wr * 64 + fr, colb = (u.pn & 3) * 256 + wc * 64 + 8 * fq;
        bf16_t* dst = kind == 0 ? Q : kind == 1 ? SG : kind == 2 ? Kb : Vb;
        const float* gsrc = kind == 0 ? qn : kn; const bool nrm = (kind == 0 || kind == 2); const float osc = kind == 0 ? qscale : 1.0f;
        f32x4 g[2][2];
#pragma unroll
        for (int bj = 0; bj < 2; ++bj)
#pragma unroll
            for (int n = 0; n < 2; ++n) g[bj][n] = *(const f32x4*)(gsrc + 32 * bj + 8 * fq + 4 * n);
        float rsv[2][4];
#pragma unroll
        for (int ai = 0; ai < 2; ++ai)
#pragma unroll
            for (int m = 0; m < 4; ++m) rsv[ai][m] = rstd_of(ssq, row0 + ai * HALF + m * 16);
#pragma unroll
        for (int ai = 0; ai < 2; ++ai)
#pragma unroll
            for (int m = 0; m < 4; ++m) { const int row = row0 + ai * HALF + m * 16; const float rs = rsv[ai][m];
                f32x4 v[2][2]; float ss = 0.f;
#pragma unroll
                for (int bj = 0; bj < 2; ++bj)
#pragma unroll
                    for (int n = 0; n < 2; ++n) { v[bj][n] = acc[ai][bj][m][n] * rs; const f32x4 t = v[bj][n]; ss += (t[0] * t[0] + t[1] * t[1]) + (t[2] * t[2] + t[3] * t[3]); }
                if (nrm) { ss += __shfl_xor(ss, 16); ss += __shfl_xor(ss, 32); const float r = __builtin_amdgcn_rsqf(ss * (1.0f / 64.0f) + 1e-6f) * osc;
#pragma unroll
                    for (int bj = 0; bj < 2; ++bj)
#pragma unroll
                        for (int n = 0; n < 2; ++n) v[bj][n] = v[bj][n] * r * g[bj][n]; }
                else if (kind == 1) {
#pragma unroll
                    for (int bj = 0; bj < 2; ++bj)
#pragma unroll
                        for (int n = 0; n < 2; ++n)
#pragma unroll
                            for (int e = 0; e < 4; ++e) v[bj][n][e] = sigmoidf_fast(v[bj][n][e]); }
                bf16_t* rowp = dst + (size_t)row * 1024 + colb;
#pragma unroll
                for (int bj = 0; bj < 2; ++bj) { const f32x4 v0 = v[bj][0], v1 = v[bj][1];
                    u32x4 w; w.x = cvt_pk_bf16(v0[0], v0[1]); w.y = cvt_pk_bf16(v0[2], v0[3]); w.z = cvt_pk_bf16(v1[0], v1[1]); w.w = cvt_pk_bf16(v1[2], v1[3]);
                    *(u32x4*)(rowp + 32 * bj) = w; } }
    }
};
struct EpiFfnUp {
    static constexpr bool PERM = true, AFTER_DRAIN = false;
    bf16_t* Hh; const float* ssq; const float* cw; float* edgeA; float* edgeG;
    __device__ __forceinline__ void operator()(const f32x4 (&acc)[2][2][4][2], const Unit& u, int wr, int wc, int fr_, int fq_) const {
        int fr = fr_, fq = fq_; asm volatile("" : "+v"(fr), "+v"(fq));
        constexpr int FF = 2816; constexpr float L2E = 1.4426950408889634f, LN2 = 0.6931471805599453f;
        const int ch0 = u.pn * 128 + wc * 32 + 8 * fq;
        const bool ge1 = fr >= 1, ge2 = fr >= 2;
        float rsv[2][4];
#pragma unroll
        for (int ai = 0; ai < 2; ++ai)
#pragma unroll
            for (int m = 0; m < 4; ++m) rsv[ai][m] = rstd_of(ssq, u.pm * BM + ai * HALF + wr * 64 + 16 * m + fr);
        f32x4 w0[2], w1[2], w2[2];
#pragma unroll
        for (int n = 0; n < 2; ++n) { w0[n] = *(const f32x4*)(cw + ch0 + 4 * n) * L2E; w1[n] = *(const f32x4*)(cw + FF + ch0 + 4 * n) * L2E; w2[n] = *(const f32x4*)(cw + 2 * FF + ch0 + 4 * n) * L2E; }
#pragma unroll
        for (int ai = 0; ai < 2; ++ai) {
            const int rowb = u.pm * BM + ai * HALF + wr * 64, grp = rowb >> 6;
            f32x4 p1prev[2], p2prev[2];
#pragma unroll
            for (int n = 0; n < 2; ++n) { p1prev[n] = (f32x4){0.f, 0.f, 0.f, 0.f}; p2prev[n] = (f32x4){0.f, 0.f, 0.f, 0.f}; }
#pragma unroll
            for (int m = 0; m < 4; ++m) {
                const float rs = rsv[ai][m]; u32x4 wv;
#pragma unroll
                for (int n = 0; n < 2; ++n) {
                    const f32x4 A = acc[ai][0][m][n] * rs, Gs = acc[ai][1][m][n] * rs;
                    if (m == 0 && fr < 2) { *(f32x4*)(edgeA + ((size_t)grp * 4 + fr) * FF + ch0 + 4 * n) = A; *(f32x4*)(edgeG + ((size_t)grp * 2 + fr) * FF + ch0 + 4 * n) = Gs; }
                    if (m == 3 && fr >= 14) { *(f32x4*)(edgeA + ((size_t)grp * 4 + 2 + (fr - 14)) * FF + ch0 + 4 * n) = A; }
                    f32x4 r1, r2, q1, q2;
#pragma unroll
                    for (int e = 0; e < 4; ++e) { r1[e] = ror1f(A[e]); r2[e] = ror2f(A[e]); q1[e] = ge1 ? r1[e] : p1prev[n][e]; q2[e] = ge2 ? r2[e] : p2prev[n][e]; }
                    const f32x4 c = w0[n] * q2 + w1[n] * q1 + w2[n] * A;
                    f32x4 d;
#pragma unroll
                    for (int e = 0; e < 4; ++e) d[e] = __builtin_amdgcn_exp2f(-c[e]);
                    d = d + 1.0f;
#pragma unroll
                    for (int e = 0; e < 4; ++e) d[e] = __builtin_amdgcn_rcpf(d[e]);
                    const f32x4 h = (c * d) * (Gs * LN2);
                    p1prev[n] = r1; p2prev[n] = r2;
                    if (n == 0) { wv.x = cvt_pk_bf16(h[0], h[1]); wv.y = cvt_pk_bf16(h[2], h[3]); } else { wv.z = cvt_pk_bf16(h[0], h[1]); wv.w = cvt_pk_bf16(h[2], h[3]); }
                }
                if (m > 0 || fr >= 2) *(u32x4*)(Hh + (size_t)(rowb + 16 * m + fr) * FF + ch0) = wv;
            }
        }
    }
};

template <class Epi, class Sched, bool ALIGN_EPI = false, bool SP2 = false>
__device__ __forceinline__ void gemm_phase(PG8_LAS unsigned char* lds, const Gemm g, const Sched& S, const Epi& E, const int tid) {
    const int wid = __builtin_amdgcn_readfirstlane(tid >> 6), lane = tid & 63, wr = wid >> 2, wc = wid & 3, fr = lane & 15, fq = lane >> 4;
    const int K = g.K, nt = K / BK;
    unsigned voffA[2], voffB[2];
#pragma unroll
    for (int i = 0; i < 2; ++i) { int R, C; stage_rc(tid * 16 + i * 8192, R, C); const int Rb = Epi::PERM ? ((R & ~31) + perm32(R & 31)) : R;
        voffA[i] = (unsigned)(R * K + C) * 2u; voffB[i] = (unsigned)(Rb * K + C) * 2u; }
    const size_t kstep = (size_t)(BK * 2);
    const size_t hstep = (size_t)HALF * K * 2;
    const size_t tstep = 2 * hstep;
    const unsigned ldsw = (unsigned)wid * 1024u;
    const int aoff = lds_byte(wr * 64 + fr, fq * 8), boff = lds_byte(wc * 32 + fr, fq * 8);
#define PG8_SA(b, h) (((b) * 2 + (h)) * HTB)
#define PG8_SB(b, h) ((4 + (b) * 2 + (h)) * HTB)
#define PG8_STAGE(bufoff, gbase, voff) do { _Pragma("unroll") for (int _i = 0; _i < 2; ++_i) \
        __builtin_amdgcn_global_load_lds((const unsigned*)((const char*)(gbase) + (voff)[_i]), (PG8_LAS unsigned*)(lds + (bufoff) + ldsw + _i * 8192), 16, 0, 0); } while (0)
#define PG8_LDA(dst, b, h) do { _Pragma("unroll") for (int m = 0; m < 4; ++m) _Pragma("unroll") for (int k = 0; k < 2; ++k) dst[m][k] = *(const PG8_LAS bf16x8*)(lds + PG8_SA(b, h) + aoff + m * 2048 + k * 1024); } while (0)
#define PG8_LDB(dst, b, h) do { _Pragma("unroll") for (int n = 0; n < 2; ++n) _Pragma("unroll") for (int k = 0; k < 2; ++k) dst[n][k] = *(const PG8_LAS bf16x8*)(lds + PG8_SB(b, h) + boff + n * 2048 + k * 1024); } while (0)
#define PG8_MMA(ai, bj, At, Bt) do { __builtin_amdgcn_s_setprio(1); _Pragma("unroll") for (int m = 0; m < 4; ++m) _Pragma("unroll") for (int n = 0; n < 2; ++n) _Pragma("unroll") for (int k = 0; k < 2; ++k) \
        acc[ai][bj][m][n] = __builtin_amdgcn_mfma_f32_16x16x32_bf16(Bt[n][k], At[m][k], acc[ai][bj][m][n], 0, 0, 0); __builtin_amdgcn_s_setprio(0); } while (0)
#define PG8_WAIT_V(n) asm volatile("s_waitcnt vmcnt(" #n ")" ::: "memory")
#define PG8_WAIT_L(n) asm volatile("s_waitcnt lgkmcnt(" #n ")" ::: "memory")
#define PG8_BAR __builtin_amdgcn_s_barrier()
#define PG8_SCHED __builtin_amdgcn_sched_barrier(0)
    Unit cur, nxt; int ui = 0;
    if (!S.next(0, cur)) return;
    f32x4 acc[2][2][4][2];
#pragma unroll
    for (int a = 0; a < 2; ++a)
#pragma unroll
        for (int b = 0; b < 2; ++b)
#pragma unroll
            for (int m = 0; m < 4; ++m)
#pragma unroll
                for (int n = 0; n < 2; ++n) acc[a][b][m][n] = (f32x4){0.f, 0.f, 0.f, 0.f};
    bf16x8 At[4][2], B0[2][2], B1[2][2];
    const char* cA = (const char*)g.A + (size_t)cur.pm * tstep; const char* cB = (const char*)g.Bt + (size_t)cur.pn * tstep;
    S.a_ready(cur);
    if constexpr (SP2) {
        PG8_STAGE(PG8_SB(0, 0), cB, voffB); PG8_STAGE(PG8_SB(0, 1), cB + hstep, voffB); PG8_STAGE(PG8_SA(0, 0), cA, voffA); PG8_STAGE(PG8_SA(0, 1), cA + hstep, voffA);
        if (wr == 1) PG8_BAR;
        PG8_WAIT_V(2); PG8_BAR;
        PG8_STAGE(PG8_SB(1, 0), cB + kstep, voffB); PG8_STAGE(PG8_SA(1, 0), cA + kstep, voffA); PG8_STAGE(PG8_SB(1, 1), cB + hstep + kstep, voffB);
        PG8_WAIT_V(6); PG8_BAR;
    } else {
        PG8_STAGE(PG8_SB(0, 0), cB, voffB); PG8_STAGE(PG8_SA(0, 0), cA, voffA); PG8_STAGE(PG8_SB(0, 1), cB + hstep, voffB); PG8_STAGE(PG8_SA(0, 1), cA + hstep, voffA);
        if (wr == 1) PG8_BAR;
        PG8_WAIT_V(4); PG8_BAR;
        PG8_STAGE(PG8_SB(1, 0), cB + kstep, voffB); PG8_STAGE(PG8_SA(1, 0), cA + kstep, voffA); PG8_STAGE(PG8_SB(1, 1), cB + hstep + kstep, voffB);
        PG8_WAIT_V(6); PG8_BAR;
    }
    for (;;) {
        const bool has_next = S.next(ui + 1, nxt);
        const char* nA = has_next ? (const char*)g.A + (size_t)nxt.pm * tstep : cA; const char* nB = has_next ? (const char*)g.Bt + (size_t)nxt.pn * tstep : cB;
        for (int t = 0; t < nt; t += 2) {
            const bool last = (t == nt - 2);
            const char* a1 = cA + (size_t)(t + 1) * kstep;
            const char* a2 = last ? nA : cA + (size_t)(t + 2) * kstep; const char* b2 = last ? nB : cB + (size_t)(t + 2) * kstep;
            const char* a3 = a2 + kstep; const char* b3 = b2 + kstep;
            if (last && has_next) S.a_ready(nxt);
            if constexpr (SP2) {
            PG8_LDB(B0, 0, 0); PG8_LDB(B1, 0, 1); PG8_SCHED; PG8_LDA(At, 0, 0); PG8_STAGE(PG8_SA(1, 1), a1 + hstep, voffA);
            PG8_WAIT_V(8); PG8_WAIT_L(0); PG8_BAR; PG8_MMA(0, 0, At, B0); PG8_MMA(0, 1, At, B1); PG8_BAR; PG8_SCHED;
            PG8_LDA(At, 0, 1); PG8_STAGE(PG8_SB(0, 0), b2, voffB); PG8_STAGE(PG8_SB(0, 1), b2 + hstep, voffB); PG8_STAGE(PG8_SA(0, 0), a2, voffA);
            PG8_WAIT_V(8); PG8_WAIT_L(0); PG8_BAR; PG8_MMA(1, 0, At, B0); PG8_MMA(1, 1, At, B1); PG8_BAR; PG8_SCHED;
            PG8_LDB(B0, 1, 0); PG8_LDB(B1, 1, 1); PG8_SCHED; PG8_LDA(At, 1, 0); PG8_STAGE(PG8_SA(0, 1), a2 + hstep, voffA);
            PG8_WAIT_V(8); PG8_WAIT_L(0); PG8_BAR; PG8_MMA(0, 0, At, B0); PG8_MMA(0, 1, At, B1); PG8_BAR; PG8_SCHED;
            PG8_LDA(At, 1, 1); PG8_STAGE(PG8_SB(1, 0), b3, voffB); PG8_STAGE(PG8_SB(1, 1), b3 + hstep, voffB); PG8_STAGE(PG8_SA(1, 0), a3, voffA);
            PG8_WAIT_V(8); PG8_WAIT_L(0); PG8_BAR; PG8_MMA(1, 0, At, B0); PG8_MMA(1, 1, At, B1); PG8_BAR; PG8_SCHED;
            } else {
            PG8_LDB(B0, 0, 0); PG8_SCHED; PG8_LDA(At, 0, 0); PG8_STAGE(PG8_SA(1, 1), a1 + hstep, voffA);
            PG8_WAIT_L(8); PG8_BAR; PG8_WAIT_L(0); PG8_MMA(0, 0, At, B0); PG8_BAR; PG8_SCHED;
            PG8_LDB(B1, 0, 1); PG8_STAGE(PG8_SB(0, 0), b2, voffB);
            PG8_BAR; PG8_WAIT_L(0); PG8_MMA(0, 1, At, B1); PG8_BAR;
            PG8_LDA(At, 0, 1); PG8_STAGE(PG8_SA(0, 0), a2, voffA);
            PG8_BAR; PG8_WAIT_L(0); PG8_MMA(1, 0, At, B0); PG8_BAR; PG8_SCHED;
            PG8_STAGE(PG8_SB(0, 1), b2 + hstep, voffB);
            PG8_WAIT_V(6); PG8_BAR; PG8_MMA(1, 1, At, B1); PG8_BAR;
            PG8_LDB(B0, 1, 0); PG8_SCHED; PG8_LDA(At, 1, 0); PG8_STAGE(PG8_SA(0, 1), a2 + hstep, voffA);
            PG8_WAIT_L(8); PG8_BAR; PG8_WAIT_L(0); PG8_MMA(0, 0, At, B0); PG8_BAR; PG8_SCHED;
            PG8_LDB(B1, 1, 1); PG8_STAGE(PG8_SB(1, 0), b3, voffB);
            PG8_BAR; PG8_WAIT_L(0); PG8_MMA(0, 1, At, B1); PG8_BAR;
            PG8_LDA(At, 1, 1); PG8_STAGE(PG8_SA(1, 0), a3, voffA);
            PG8_BAR; PG8_WAIT_L(0); PG8_MMA(1, 0, At, B0); PG8_BAR; PG8_SCHED;
            PG8_STAGE(PG8_SB(1, 1), b3 + hstep, voffB);
            PG8_WAIT_V(6); PG8_BAR; PG8_MMA(1, 1, At, B1); PG8_BAR;
            }
        }
        if constexpr (ALIGN_EPI) { if (wr == 0) PG8_BAR; }
        if constexpr (!Epi::AFTER_DRAIN) { E(acc, cur, wr, wc, fr, fq); S.done(cur); }
        if (!has_next) break;
#pragma unroll
        for (int a = 0; a < 2; ++a)
#pragma unroll
            for (int b = 0; b < 2; ++b)
#pragma unroll
                for (int m = 0; m < 4; ++m)
#pragma unroll
                    for (int n = 0; n < 2; ++n) acc[a][b][m][n] = (f32x4){0.f, 0.f, 0.f, 0.f};
        cur = nxt; cA = nA; cB = nB; ++ui;
        if constexpr (ALIGN_EPI) { if (wr == 1) PG8_BAR; }
    }
    PG8_WAIT_V(0);
    if constexpr (!ALIGN_EPI) { if (wr == 0) PG8_BAR; }
    PG8_BAR;
    if constexpr (Epi::AFTER_DRAIN) { E.fused(acc, cur, wr, wc, fr, fq, lds, wid, lane); S.done(cur); }
#undef PG8_SA
#undef PG8_SB
#undef PG8_STAGE
#undef PG8_LDA
#undef PG8_LDB
#undef PG8_MMA
#undef PG8_WAIT_V
#undef PG8_WAIT_L
#undef PG8_BAR
#undef PG8_SCHED
}
}

#ifndef PG8_SP2
#define PG8_SP2 true
#endif
#ifndef PG8_ALIGN
#define PG8_ALIGN true
#endif
#include <hip/hip_bf16.h>
#include <cmath>
namespace attn_body {
using bf16=__hip_bfloat16;
using bf16x8=__attribute__((ext_vector_type(8)))short;
using s16x4=__attribute__((ext_vector_type(4)))short;
using f32x16=__attribute__((ext_vector_type(16)))float;
using u32x4=__attribute__((ext_vector_type(4)))unsigned;
using f32x4v=__attribute__((ext_vector_type(4)))float;
constexpr int BATCH=4,NHEAD=16,SEQ=8192,D=64,DM=NHEAD*D;
constexpr int NW=8,QBLK=32,QB=QBLK*NW,KVBLK=64,NQB=SEQ/QB;
constexpr int ATTN_PITCH=DM, ATTN_UNIT_ROWS=QB;
__device__ __forceinline__ int crow(int r,int hi){return (r&3)+8*(r>>2)+4*hi;}
#define SBAR() __builtin_amdgcn_sched_barrier(0)
__device__ __forceinline__ void cmask(f32x16&p0,f32x16&p1,int jb,int qrel,int hi){
  const float NEG=-INFINITY; int q2=qrel-64*jb-4*hi; asm volatile("":"+v"(q2));
  #pragma unroll
  for(int r=0;r<16;++r){const int c=(r&3)+8*(r>>2); if(c>q2)p0[r]=NEG; if(c+32>q2)p1[r]=NEG;}
}

constexpr int NSLOT=3, SLOTB=8192;
constexpr int LDS_K=0, LDS_V=NSLOT*SLOTB, LDS_WS=2*NSLOT*SLOTB, LDS_OST=LDS_WS+NW*64*4, LDS_BYTES=LDS_OST+NW*4096, LDS_KX=86016, LDS_TOTAL=LDS_KX+SEQ*8;
constexpr float C2=0.125f*1.4426950408889634f;
__device__ __forceinline__ void glds16(const void*gsrc,unsigned lds_dst){unsigned keep;
  asm volatile("s_mov_b32 %0, m0\n\ts_mov_b32 m0, %2\n\ts_nop 0\n\tglobal_load_lds_dwordx4 %1, off\n\ts_mov_b32 m0, %0":"=&s"(keep):"v"(gsrc),"s"(lds_dst):"memory");}
__device__ __forceinline__ float max3f(float a,float b,float c){float r;asm("v_max3_f32 %0, %1, %2, %3":"=v"(r):"v"(a),"v"(b),"v"(c));return r;}
__device__ __forceinline__ float max2f(float a,float b){float r;asm("v_max_f32_e32 %0, %1, %2":"=v"(r):"v"(a),"v"(b));return r;}
__device__ __forceinline__ float fadd_s(float a,float b){float r;asm("v_add_f32_e32 %0, %1, %2":"=v"(r):"v"(a),"v"(b));return r;}
__device__ __forceinline__ float fsub_s(float a,float b){float r;asm("v_sub_f32_e32 %0, %1, %2":"=v"(r):"v"(a),"v"(b));return r;}
typedef float f32x2_t __attribute__((ext_vector_type(2))); typedef __bf16 bf16x2_t __attribute__((ext_vector_type(2)));
__device__ __forceinline__ unsigned cvtpk_s(float lo,float hi){f32x2_t v={lo,hi};bf16x2_t b=__builtin_convertvector(v,bf16x2_t);return __builtin_bit_cast(unsigned,b);}
#define WAIT_BAR(N) asm volatile("s_waitcnt vmcnt(" #N ") lgkmcnt(0)\n\ts_barrier":::"memory")

__device__ __forceinline__ void qkt(f32x16&p0,f32x16&p1,const char*Kslot,const bf16x8*qr,const f32x16&negm,int r32,int hi){
  const char*kb=Kslot+hi*1024+r32*16;
  #pragma unroll
  for(int d0=0;d0<4;++d0){
    const bf16x8 b0=*reinterpret_cast<const bf16x8*>(kb+d0*2048);
    const bf16x8 b1=*reinterpret_cast<const bf16x8*>(kb+d0*2048+512);
    if(d0==0){p0=__builtin_amdgcn_mfma_f32_32x32x16_bf16(b0,qr[0],f32x16{},0,0,0);p1=__builtin_amdgcn_mfma_f32_32x32x16_bf16(b1,qr[0],f32x16{},0,0,0);}
    else{p0=__builtin_amdgcn_mfma_f32_32x32x16_bf16(b0,qr[d0],p0,0,0,0);p1=__builtin_amdgcn_mfma_f32_32x32x16_bf16(b1,qr[d0],p1,0,0,0);}}
}
typedef __attribute__((address_space(3))) const char* lds_cptr;
typedef short v4i16_t __attribute__((ext_vector_type(4)));
__device__ __forceinline__ void kload8(bf16x8*kf,lds_cptr kp){
  kf[0]=*(const __attribute__((address_space(3))) bf16x8*)(kp);      kf[1]=*(const __attribute__((address_space(3))) bf16x8*)(kp+512);
  kf[2]=*(const __attribute__((address_space(3))) bf16x8*)(kp+2048); kf[3]=*(const __attribute__((address_space(3))) bf16x8*)(kp+2560);
  kf[4]=*(const __attribute__((address_space(3))) bf16x8*)(kp+4096); kf[5]=*(const __attribute__((address_space(3))) bf16x8*)(kp+4608);
  kf[6]=*(const __attribute__((address_space(3))) bf16x8*)(kp+6144); kf[7]=*(const __attribute__((address_space(3))) bf16x8*)(kp+6656);
}
__device__ __forceinline__ void kload2(bf16x8*kf,lds_cptr kp,int j){ kf[2*j]=*(const __attribute__((address_space(3))) bf16x8*)(kp+j*2048); kf[2*j+1]=*(const __attribute__((address_space(3))) bf16x8*)(kp+j*2048+512); }
__device__ __forceinline__ s16x4 vtr(lds_cptr p){ return __builtin_bit_cast(s16x4,__builtin_amdgcn_ds_read_tr16_b64_v4i16((__attribute__((address_space(3))) v4i16_t*)p)); }
__device__ __forceinline__ float rowmax(const f32x16&p0,const f32x16&p1){
  float a=max3f(p0[0],p0[1],p1[0]),b=max3f(p0[2],p0[3],p1[1]);a=max3f(a,p1[2],p1[3]);
  #pragma unroll
  for(int r=4;r<16;r+=4){a=max3f(a,p0[r],p0[r+1]);b=max3f(b,p0[r+2],p0[r+3]);a=max3f(a,p1[r],p1[r+1]);b=max3f(b,p1[r+2],p1[r+3]);}
  const float m=max2f(a,b);
  auto rr=__builtin_amdgcn_permlane32_swap(__float_as_uint(m),__float_as_uint(m),false,false);
  return max2f(__uint_as_float(rr[0]),__uint_as_float(rr[1]));
}
__device__ __forceinline__ void pv(f32x16*o,int vb,bf16x8 pa0,bf16x8 pa1,bf16x8 pa2,bf16x8 pa3){
  #pragma unroll
  for(int d0=0;d0<2;++d0){s16x4 lo[4],hi[4];
    #pragma unroll
    for(int ks=0;ks<4;++ks){
      asm volatile("ds_read_b64_tr_b16 %0,%1 offset:%c2":"=&v"(lo[ks]):"v"(vb),"i"(d0*4096+ks*1024):"memory");
      asm volatile("ds_read_b64_tr_b16 %0,%1 offset:%c2":"=&v"(hi[ks]):"v"(vb),"i"(d0*4096+ks*1024+512):"memory");}
    asm volatile("s_waitcnt lgkmcnt(0)":::"memory");SBAR();
    #define PK(k) (bf16x8){lo[k][0],lo[k][1],lo[k][2],lo[k][3],hi[k][0],hi[k][1],hi[k][2],hi[k][3]}
    o[d0]=__builtin_amdgcn_mfma_f32_32x32x16_bf16(pa0,PK(0),o[d0],0,0,0);
    o[d0]=__builtin_amdgcn_mfma_f32_32x32x16_bf16(pa1,PK(1),o[d0],0,0,0);
    o[d0]=__builtin_amdgcn_mfma_f32_32x32x16_bf16(pa2,PK(2),o[d0],0,0,0);
    o[d0]=__builtin_amdgcn_mfma_f32_32x32x16_bf16(pa3,PK(3),o[d0],0,0,0);
    #undef PK
  }
}

#ifndef ATTN_STORE16
#define ATTN_STORE16(p,v) (*(u32x4*)(p)=(v))
#endif
template<int THRL> __device__ __forceinline__ void attn_unit(int b,int h,int qb,const bf16*Q,const bf16*__restrict__ K,const bf16*__restrict__ V,bf16*O,const bf16*SG,const unsigned*KXG,const int j0,const float BND,char*shm,const int tid,const bool kv0=false){
  const int lane=tid&63,r32=lane&31,hi=lane>>5; const int wid=__builtin_amdgcn_readfirstlane(tid>>6);
  const long rowbase=(long)b*SEQ; const int q0=qb*QB;
  const bf16*Qw=Q+(rowbase+q0+wid*QBLK)*DM+h*D;
  const int NT0=(q0+QB)/KVBLK;
  const bf16*Kh=K+((kv0?0l:rowbase)+(long)j0*KVBLK)*DM+(kv0?0:h)*D,*Vh=V+((kv0?0l:rowbase)+(long)j0*KVBLK)*DM+(kv0?0:h)*D;
  const unsigned lds0=(unsigned)(uintptr_t)shm;
  float*wsf=(float*)(shm+LDS_WS)+wid*64;
  const bf16*ksrc=Kh+(long)lane*DM+wid*8;
  const bf16*vsrc=Vh+(long)(16*(wid&3)+(lane>>2))*DM+(wid>>2)*32+(lane&3)*8;
  const unsigned kdst=lds0+LDS_K+wid*1024, vdst=lds0+LDS_V+wid*1024;
  #define DMA_K(t,slot) glds16(ksrc+(long)(t)*KVBLK*DM,(unsigned)__builtin_amdgcn_readfirstlane(kdst+(slot)))
  #define DMA_V(t,slot) glds16(vsrc+(long)(t)*KVBLK*DM,(unsigned)__builtin_amdgcn_readfirstlane(vdst+(slot)))
  const int vb0=(int)(lds0+LDS_V)+((lane>>4)&1)*32+(lane&3)*8+(4*hi+((lane&15)>>2))*64;
  const char*Kbase=shm+LDS_K; bf16x8 kf[8];
  const lds_cptr shm3=(lds_cptr)shm; const lds_cptr kp0=shm3+LDS_K+hi*1024+r32*16; const lds_cptr vp0=shm3+LDS_V+((lane>>4)&1)*32+(lane&3)*8+(4*hi+((lane&15)>>2))*64;
  const int NT=NT0-j0;
  DMA_K(0,0);DMA_V(0,0);DMA_K(1,SLOTB);
  bf16x8 qr[4];
  #pragma unroll
  for(int d0=0;d0<4;++d0)qr[d0]=*reinterpret_cast<const bf16x8*>(&Qw[(long)r32*DM+d0*16+hi*8]);
  float mhat=0.f,l_reg=0.f;f32x16 o[2];o[0]=f32x16{};o[1]=f32x16{};f32x16 negm=f32x16{};
  const int qrel=wid*QBLK+r32;
  #define CMASK(P0,P1,t) do{int jb_=(t)-(NT-4); if(jb_>=0)cmask(P0,P1,jb_,qrel,hi);}while(0)
  #define START(P0,P1) do{ _Pragma("unroll") for(int r=0;r<16;++r)P0[r]=__builtin_amdgcn_exp2f(P0[r]); }while(0)
  #define RESC() do{}while(0)
  f32x16 pA0,pA1,pB0,pB1;
  int sl_prev=0,sl_cur=0,sl_next=SLOTB;
  #define ROT() do{sl_prev=sl_cur;sl_cur=sl_next;sl_next=(sl_next==(NSLOT-1)*SLOTB)?0:sl_next+SLOTB;}while(0)
  typedef __attribute__((address_space(3))) char lds_char; typedef __attribute__((ext_vector_type(2))) unsigned u32x2v;
  typedef __attribute__((address_space(3))) u32x4 lds_u32x4; typedef __attribute__((address_space(3))) u32x2v lds_u32x2;
  lds_char* const kx3=(lds_char*)shm+LDS_KX+j0*512;
  { lds_char* const kxw=(lds_char*)shm+LDS_KX; const u32x4* kxs=(const u32x4*)(KXG+(long)(b*NHEAD+h)*SEQ*2);
    int tid_n=tid; asm volatile("":"+v"(tid_n));
    for(int p_=j0*(KVBLK/2)+tid_n;p_<(q0+QB)/2;p_+=NW*64){ *(lds_u32x4*)(kxw+p_*16)=kxs[p_]; } }
  u32x4 qxv=(hi==0)?(u32x4){0x3f803f80u,0x00003f80u,0u,0u}:(u32x4){0u,0u,0u,0u};
  #define qx __builtin_bit_cast(bf16x8,qxv)
  #define SETQX() do{ const float nm_=-mhat; const unsigned h_=cvtpk_s(nm_,0.f)&0xffffu; const float r1_=nm_-__uint_as_float(h_<<16); const unsigned m_=cvtpk_s(r1_,0.f)&0xffffu; \
    const float r2_=r1_-__uint_as_float(m_<<16); const unsigned l_=cvtpk_s(r2_,0.f)&0xffffu; qxv.y=(hi==0)?(0x3f80u|(h_<<16)):0u; qxv.z=(hi==0)?(m_|(l_<<16)):0u; }while(0)
  u32x2v kxa,kxb;
  #define KXLD(t) do{ const lds_u32x2* p_=(const lds_u32x2*)(kx3+(t)*512+r32*8); kxa=p_[0]; kxb=p_[32]; }while(0)
  #define KXF(v) __builtin_bit_cast(bf16x8,(u32x4){(v).x,(v).y,0x3f803f80u,0u})
  { const unsigned* kq_=KXG+((long)(b*NHEAD+h)*SEQ+q0+wid*QBLK+r32)*2; const unsigned w0_=kq_[0], w1_=kq_[1];
    mhat=(__uint_as_float(w0_<<16)+__uint_as_float(w0_&0xffff0000u))+__uint_as_float(w1_<<16)+BND; SETQX(); }
  DMA_K(2,2*SLOTB);
  WAIT_BAR(3);
  KXLD(0); qkt(pA0,pA1,Kbase,qr,negm,r32,hi); pA0=__builtin_amdgcn_mfma_f32_32x32x16_bf16(KXF(kxa),qx,pA0,0,0,0); pA1=__builtin_amdgcn_mfma_f32_32x32x16_bf16(KXF(kxb),qx,pA1,0,0,0);
  asm volatile("s_nop 15\n\ts_nop 7":"+v"(pA0),"+v"(pA1));CMASK(pA0,pA1,0);
  START(pA0,pA1);
  _Pragma("unroll") for(int r=0;r<16;++r)pA1[r]=__builtin_amdgcn_exp2f(pA1[r]);
  WAIT_BAR(0);
  DMA_K(3,0);DMA_V(1,SLOTB);
  ROT();
  kload8(kf,kp0+sl_cur); KXLD(1);
  WAIT_BAR(2);
  s16x4 vlo[8],vhi[8]; u32x4 pw0,pw1,pw2,pw3;
  #define PKW(P,B) cvtpk_s(P[B],P[B+1])
  #define PAF(k) __builtin_bit_cast(bf16x8,pw##k)
  #define VFR(i) (bf16x8){vlo[i][0],vlo[i][1],vlo[i][2],vlo[i][3],vhi[i][0],vhi[i][1],vhi[i][2],vhi[i][3]}
  #define PIN(x) asm volatile("":"+v"(x))
  #define MX3(a,b,c) __builtin_fmaxf(__builtin_fmaxf((a),(b)),(c))
  #define GAPA(MF,A0,A1,A2,A3,W0,W1,PW) do{ MF; sacc+=A0; sacc+=A1; sacc+=A2; sacc+=A3; PIN(sacc); W0; W1; PIN(PW); SBAR(); }while(0)
  #define EX(v) __builtin_amdgcn_exp2f(v)
  #define GAPB(MF,X,B) do{ MF; X[B]=EX(X[B]); X[B+1]=EX(X[B+1]); X[B+2]=EX(X[B+2]); X[B+3]=EX(X[B+3]); PIN(X); SBAR(); }while(0)
  #define VRD(i) do{ vlo[i]=vtr(vp_+(((i)>>2)*4096+((i)&3)*1024)); vhi[i]=vtr(vp_+(((i)>>2)*4096+((i)&3)*1024+512)); }while(0)
  #define KRD(G,j) do{ if(G){ kload2(kf,kp0+sl_next,j); SBAR(); } }while(0)
  #define KXRD(G,t) do{ if(G){ KXLD((t)+1); SBAR(); } }while(0)
  #define STEP(C0,C1,P0,P1,t,GK,GV,GL) do{ SBAR(); \
    const lds_cptr vp_=vp0+sl_prev; \
    VRD(0); SBAR(); float sacc=(P0[0]+P0[1]); \
    GAPA(C0=__builtin_amdgcn_mfma_f32_32x32x16_bf16(kf[0],qr[0],f32x16{},0,0,0), P0[2],P0[3],P0[4],P0[5],     pw0[0]=PKW(P0,0), pw0[1]=PKW(P0,2), pw0); \
    VRD(4); SBAR(); GAPA(C1=__builtin_amdgcn_mfma_f32_32x32x16_bf16(kf[1],qr[0],f32x16{},0,0,0), P0[6],P0[7],P0[8],P0[9],     pw0[2]=PKW(P0,4), pw0[3]=PKW(P0,6), pw0); \
    VRD(1); SBAR(); GAPA(C0=__builtin_amdgcn_mfma_f32_32x32x16_bf16(kf[2],qr[1],C0,0,0,0),   P0[10],P0[11],P0[12],P0[13], pw1[0]=PKW(P0,8), pw1[1]=PKW(P0,10), pw1); \
    VRD(5); SBAR(); GAPA(C1=__builtin_amdgcn_mfma_f32_32x32x16_bf16(kf[3],qr[1],C1,0,0,0),   P0[14],P0[15],P1[0],P1[1],   pw1[2]=PKW(P0,12),pw1[3]=PKW(P0,14), pw1); \
    VRD(2); SBAR(); GAPA(C0=__builtin_amdgcn_mfma_f32_32x32x16_bf16(kf[4],qr[2],C0,0,0,0),   P1[2],P1[3],P1[4],P1[5],     pw2[0]=PKW(P1,0), pw2[1]=PKW(P1,2), pw2); \
    VRD(6); SBAR(); GAPA(C1=__builtin_amdgcn_mfma_f32_32x32x16_bf16(kf[5],qr[2],C1,0,0,0),   P1[6],P1[7],P1[8],P1[9],     pw2[2]=PKW(P1,4), pw2[3]=PKW(P1,6), pw2); \
    VRD(3); SBAR(); GAPA(C0=__builtin_amdgcn_mfma_f32_32x32x16_bf16(kf[6],qr[3],C0,0,0,0),   P1[10],P1[11],P1[12],P1[13], pw3[0]=PKW(P1,8), pw3[1]=PKW(P1,10), pw3); \
    VRD(7); SBAR(); GAPA(C1=__builtin_amdgcn_mfma_f32_32x32x16_bf16(kf[7],qr[3],C1,0,0,0),   P1[14],P1[15],0.f,0.f,       pw3[2]=PKW(P1,12),pw3[3]=PKW(P1,14), pw3); \
    C0=__builtin_amdgcn_mfma_f32_32x32x16_bf16(KXF(kxa),qx,C0,0,0,0); C1=__builtin_amdgcn_mfma_f32_32x32x16_bf16(KXF(kxb),qx,C1,0,0,0); SBAR(); \
    l_reg+=sacc; \
    if(GK){DMA_K((t)+3,sl_cur);} if(GV){DMA_V((t)+1,sl_next);} \
    CMASK(C0,C1,t); \
    SBAR(); \
    GAPB(o[0]=__builtin_amdgcn_mfma_f32_32x32x16_bf16(PAF(0),VFR(0),o[0],0,0,0), C0,0); \
    GAPB(o[1]=__builtin_amdgcn_mfma_f32_32x32x16_bf16(PAF(0),VFR(4),o[1],0,0,0), C0,4); \
    KRD(GL,0); GAPB(o[0]=__builtin_amdgcn_mfma_f32_32x32x16_bf16(PAF(1),VFR(1),o[0],0,0,0), C0,8); \
    KRD(GL,1); GAPB(o[1]=__builtin_amdgcn_mfma_f32_32x32x16_bf16(PAF(1),VFR(5),o[1],0,0,0), C0,12); \
    KRD(GL,2); GAPB(o[0]=__builtin_amdgcn_mfma_f32_32x32x16_bf16(PAF(2),VFR(2),o[0],0,0,0), C1,0); \
    KRD(GL,3); GAPB(o[1]=__builtin_amdgcn_mfma_f32_32x32x16_bf16(PAF(2),VFR(6),o[1],0,0,0), C1,4); KXRD(GL,t); \
    GAPB(o[0]=__builtin_amdgcn_mfma_f32_32x32x16_bf16(PAF(3),VFR(3),o[0],0,0,0), C1,8); \
    GAPB(o[1]=__builtin_amdgcn_mfma_f32_32x32x16_bf16(PAF(3),VFR(7),o[1],0,0,0), C1,12); \
    }while(0)
  int t=1;
  #undef CMASK
  #define CMASK(P0,P1,t) do{}while(0)
  for(;t+5<NT;t+=2){
    STEP(pB0,pB1,pA0,pA1,t,true,true,true);     WAIT_BAR(2); RESC(); ROT();
    STEP(pA0,pA1,pB0,pB1,t+1,true,true,true);   WAIT_BAR(2); RESC(); ROT();
  }
  #undef CMASK
  #define CMASK(P0,P1,t) do{int jb_=(t)-(NT-4); if(jb_>=0)cmask(P0,P1,jb_,qrel,hi);}while(0)
  #define ENDW(tt) do{ if((tt)+3<NT){WAIT_BAR(2);} else if((tt)+2<NT){WAIT_BAR(1);} else {WAIT_BAR(0);} }while(0)
  for(;t+1<NT;t+=2){
    STEP(pB0,pB1,pA0,pA1,t,(t+3<NT),(t+1<NT),(t+1<NT));       ENDW(t);   RESC(); ROT();
    STEP(pA0,pA1,pB0,pB1,t+1,(t+4<NT),(t+2<NT),(t+2<NT));     ENDW(t+1); RESC(); ROT();
  }
  STEP(pB0,pB1,pA0,pA1,NT-1,false,false,false); RESC();
  { float sacc=pB0[0]+pB0[1]; _Pragma("unroll") for(int r=2;r<16;++r)sacc+=pB0[r]; _Pragma("unroll") for(int r=0;r<16;++r)sacc+=pB1[r]; l_reg+=sacc;
    pw0=(u32x4){PKW(pB0,0),PKW(pB0,2),PKW(pB0,4),PKW(pB0,6)};pw1=(u32x4){PKW(pB0,8),PKW(pB0,10),PKW(pB0,12),PKW(pB0,14)};pw2=(u32x4){PKW(pB1,0),PKW(pB1,2),PKW(pB1,4),PKW(pB1,6)};pw3=(u32x4){PKW(pB1,8),PKW(pB1,10),PKW(pB1,12),PKW(pB1,14)};
    SBAR(); pv(o,vb0+sl_cur,PAF(0),PAF(1),PAF(2),PAF(3)); }
  #undef PKW
  #undef PAF
  #undef VFR
  #undef PIN
  #undef MX3
  #undef GAPA
  #undef GAPB
  #undef EX
  #undef VRD
  #undef KRD
  #undef STEP
  #undef ENDW
  {auto rr=__builtin_amdgcn_permlane32_swap(__float_as_uint(l_reg),__float_as_uint(l_reg),false,false);l_reg=__uint_as_float(rr[0])+__uint_as_float(rr[1]);}
  if(hi==0)wsf[32+r32]=l_reg;asm volatile("s_waitcnt lgkmcnt(0)":::"memory");
  float rli[16];
  #pragma unroll
  for(int r=0;r<16;++r)rli[r]=__builtin_amdgcn_rcpf(wsf[32+crow(r,hi)]);
  bf16*Ow=O+(rowbase+q0+wid*QBLK)*DM+h*D; const long sgd=(const char*)SG-(const char*)O;

  { bf16*stg=(bf16*)(shm+LDS_OST)+wid*2048;
    #pragma unroll
    for(int r=0;r<16;++r){const int orow=crow(r,hi);
      #pragma unroll
      for(int d0=0;d0<2;++d0)stg[orow*64+d0*32+r32]=__float2bfloat16(o[d0][r]*rli[r]);}
    asm volatile("s_waitcnt lgkmcnt(0)":::"memory");
    int lane_e=lane; asm volatile("":"+v"(lane_e));
    u32x4 gvv[4];
    #pragma unroll
    for(int i=0;i<4;++i)gvv[i]=*(const u32x4*)((const char*)(Ow+(long)(i*8+(lane_e>>3))*DM+(lane_e&7)*8)+sgd);
    #pragma unroll
    for(int i=0;i<4;++i){const int row=i*8+(lane_e>>3),ch=lane_e&7; u32x4 v=*(const u32x4*)(stg+row*64+ch*8); const u32x4 gvi=gvv[i];
      #pragma unroll
      for(int k=0;k<4;++k){ const float lo_=__builtin_bit_cast(float,v[k]<<16)*__builtin_bit_cast(float,gvi[k]<<16), hi_=__builtin_bit_cast(float,v[k]&0xffff0000u)*__builtin_bit_cast(float,gvi[k]&0xffff0000u); v[k]=cvtpk_s(lo_,hi_); }
      ATTN_STORE16(Ow+(long)row*DM+ch*8,v);} }
  asm volatile("s_waitcnt lgkmcnt(0)\n\ts_barrier":::"memory");
  #undef KXLD
  #undef qx
  #undef SETQX
  #undef KXF
  #undef KXRD
  #undef DMA_K
  #undef DMA_V
  #undef CMASK
  #undef START
  #undef RESC
  #undef ROT
}
constexpr int ATTN_LDS_BYTES=LDS_BYTES;
struct AttnTensors { const bf16* Q; const bf16* K; const bf16* V; bf16* O; const bf16* SG; const unsigned* KXG; const unsigned* J0T; };
struct AttnUnit { int bh; int qb; };
struct StaticOrder {
  int vcu;
  __device__ __forceinline__ explicit StaticOrder(int grid,int block):vcu((block%8)*(grid/8)+block/8){}
  __device__ __forceinline__ bool next(int i,AttnUnit&u)const{ if(i>=8)return false; const int s=vcu&7,j=i&3; u.bh=(vcu>>3)+32*(i>>2); u.qb=(j==0)?s:(j==1)?15-s:(j==2)?16+s:31-s; return true; }
  __device__ __forceinline__ void a_ready(const AttnUnit&)const{}
  __device__ __forceinline__ void done(const AttnUnit&)const{}
};
constexpr int LDS_QW=LDS_TOTAL, LDS_J0=LDS_TOTAL+16, LDS_ATT_END=LDS_J0+BATCH*NHEAD*NQB*4;
template<int THRL=8> __device__ __forceinline__ void attn_phase(char*lds,const AttnTensors&T,unsigned*ctr,const float BND,const int tid,const bool kv0=false){
  volatile __attribute__((address_space(3))) unsigned* qw=(volatile __attribute__((address_space(3))) unsigned*)((__attribute__((address_space(3))) char*)lds+LDS_QW);
  unsigned nxt=0u;
  volatile __attribute__((address_space(3))) unsigned* j0l=(volatile __attribute__((address_space(3))) unsigned*)((__attribute__((address_space(3))) char*)lds+LDS_J0);
  for(int i_=tid;i_<BATCH*NHEAD*NQB;i_+=NW*64)j0l[i_]=T.J0T[i_];
  if(tid==0){ qw[0]=__hip_atomic_fetch_add(ctr,1u,__ATOMIC_RELAXED,__HIP_MEMORY_SCOPE_AGENT); }
  asm volatile("s_waitcnt vmcnt(0) lgkmcnt(0)\n\ts_barrier":::"memory");
  unsigned cur=(unsigned)__builtin_amdgcn_readfirstlane((int)qw[0]);
  while(cur<(unsigned)(BATCH*NHEAD*NQB)){
    if(tid==0) nxt=__hip_atomic_fetch_add(ctr,1u,__ATOMIC_RELAXED,__HIP_MEMORY_SCOPE_AGENT);
    const int bh=(int)(cur&63u), qb=NQB-1-(int)(cur>>6);
    attn_unit<THRL>(bh/NHEAD,bh%NHEAD,qb,T.Q,T.K,T.V,T.O,T.SG,T.KXG,__builtin_amdgcn_readfirstlane((int)j0l[bh*NQB+qb]),BND,lds,tid,kv0);
    if(tid==0) qw[0]=nxt;
    asm volatile("s_waitcnt lgkmcnt(0)\n\ts_barrier":::"memory");
    cur=(unsigned)__builtin_amdgcn_readfirstlane((int)qw[0]);
  }
}
#undef SBAR
#undef WAIT_BAR
}
namespace cg = cooperative_groups;
#ifndef PROBE_X
#define PROBE_X 0
#endif
#ifndef MK_MULTI
#define MK_MULTI 0
#endif
constexpr int NWAVES = 8, NTHREADS = NWAVES * 64;
constexpr int BATCH = 4, T = 8192, D = 1024, H = 16, HD = 64, FF = 2816, M = BATCH * T;
constexpr int N_PHASES = 22;
constexpr size_t MiB = 1u << 20;
constexpr size_t WS_CTL = 1536 * 1024, CTL_BYTES = 16384;
constexpr size_t WS_WF = 2 * MiB;
constexpr size_t WS_WIN = 4 * MiB, WS_WOUT = 16 * MiB, WS_WQGKV = 20 * MiB, WS_WQG3 = 28 * MiB, WS_WBO = 32 * MiB, WS_WUP = 36 * MiB, WS_WDN = 80 * MiB;
constexpr size_t WS_XB = 104 * MiB;
constexpr size_t WS_K = 168 * MiB, WS_V = 232 * MiB;
constexpr size_t WS_ACT = 296 * MiB;
constexpr size_t WS_SG = WS_ACT + 64 * MiB;
constexpr size_t WS_EDGEA = 472 * MiB, WS_EDGEG = 494 * MiB;
constexpr size_t WS_FLT = 505 * MiB, WS_CT = 507 * MiB, WS_END = 509 * MiB;
static_assert(WS_WDN + 4 * (size_t)FF * D * 2 <= WS_XB && WS_ACT + (size_t)M * FF * 2 <= WS_EDGEA && WS_EDGEA + 512ull * 4 * FF * 4 <= WS_EDGEG && WS_EDGEG + 512ull * 2 * FF * 4 <= WS_FLT, "d_ws map");
constexpr int RING_BYTES = 131072, LDS_BYTES = 163840, LDS_BARST = LDS_BYTES - 16;
static_assert(attn_body::LDS_ATT_END <= LDS_BYTES - 16, "LDS map");

#define LAS __attribute__((address_space(3)))
typedef unsigned short bf16;
typedef unsigned v4u __attribute__((ext_vector_type(4)));
typedef unsigned v2u __attribute__((ext_vector_type(2)));
typedef float f32x4 __attribute__((ext_vector_type(4)));
typedef short bf16x8 __attribute__((ext_vector_type(8)));
#define LDS_WAIT() asm volatile("s_waitcnt lgkmcnt(0)" ::: "memory")
__device__ __forceinline__ unsigned f2bf(float f) { unsigned u = __builtin_bit_cast(unsigned, f); return (u + 0x7fffu + ((u >> 16) & 1u)) >> 16; }
__device__ __forceinline__ unsigned pk2(float lo, float hi) { return f2bf(lo) | (f2bf(hi) << 16); }
__device__ __forceinline__ float bflo(unsigned u) { return __builtin_bit_cast(float, u << 16); }
__device__ __forceinline__ float bfhi(unsigned u) { return __builtin_bit_cast(float, u & 0xffff0000u); }
__device__ __forceinline__ float wave_sum(float v) {
#pragma unroll
    for (int o = 1; o < 64; o <<= 1) v += __shfl_xor(v, o);
    return v;
}
__device__ __forceinline__ void tr_item(const float* W, int ldw, int k0, int n0, const float* gain, bf16* WT, int Kd, int drow0, int nvalid, LAS float* scr, int lane) {
    int cc = n0 + (lane & 31); if (cc >= ldw) cc = ldw - 1;
#pragma unroll 8
    for (int i = 0; i < 32; ++i) { const int kk = 2 * i + (lane >> 5); float w = W[(size_t)(k0 + kk) * ldw + cc]; if (gain) w *= gain[k0 + kk]; scr[kk * 33 + (lane & 31)] = w; }
    LDS_WAIT(); asm volatile("" ::: "memory");
    const int c = lane & 7;
#pragma unroll
    for (int j = 0; j < 4; ++j) { const int n = (lane >> 3) + 8 * j; const LAS float* s = scr + (8 * c) * 33 + n;
        v4u o; o.x = pk2(s[0 * 33], s[1 * 33]); o.y = pk2(s[2 * 33], s[3 * 33]); o.z = pk2(s[4 * 33], s[5 * 33]); o.w = pk2(s[6 * 33], s[7 * 33]);
        if (n < nvalid) *(v4u*)(WT + (size_t)(drow0 + n) * Kd + k0 + 8 * c) = o; }
    LDS_WAIT(); asm volatile("" ::: "memory");
}
__device__ __forceinline__ int headperm_row(int L0) { const int pn = L0 >> 8, w = L0 & 255; return 256 * pn + 128 * ((w & 63) >> 5) + 32 * (w >> 6); }
__device__ __forceinline__ int ffnup_row(int L0) { const int g = L0 >= FF ? 1 : 0, ch = L0 - g * FF; return 256 * (ch >> 7) + 128 * g + (ch & 127); }

#define XB_TMO      128
#define XB_XCNT(j)  (256  + 64 * (j))
#define XB_XSUB(j)  (1280 + 64 * (j))
#define XB_XGEN(j)  (2304 + 64 * (j))
#define XB_TOP      3328
#define XB_TOPGEN   3392
#define XCD_BAR_WORDS 3456
#define XB_SPIN_CAP (1u << 18)

__device__ __forceinline__ unsigned xb_ld(unsigned* p)              { return __hip_atomic_load(p, __ATOMIC_RELAXED, __HIP_MEMORY_SCOPE_AGENT); }
__device__ __forceinline__ unsigned xb_add(unsigned* p, unsigned v) { return __hip_atomic_fetch_add(p, v, __ATOMIC_RELAXED, __HIP_MEMORY_SCOPE_AGENT); }
__device__ __forceinline__ unsigned xb_xcc_id() { return (unsigned)__builtin_amdgcn_s_getreg((3 << 11) | 20) & 0xFu; }
#define XB_SPIN(cond, bar) do { unsigned _sp = 0; while (cond) { __builtin_amdgcn_s_sleep(1); \
    if ((++_sp & 255u) == 0u) { if (xb_ld(&(bar)[XB_TMO])) break; if (_sp > XB_SPIN_CAP) { atomicAdd(&(bar)[XB_TMO], 1u); break; } } } } while (0)

struct XcdBarrier {
    unsigned* bar; unsigned x;
    volatile LAS unsigned* st;
};

__device__ __forceinline__ XcdBarrier xcd_barrier_post(unsigned* bar, volatile LAS unsigned* st) {
    XcdBarrier b; b.bar = bar; b.x = xb_xcc_id(); b.st = st;
    if (threadIdx.x == 0) (void)xb_add(&bar[XB_XCNT(b.x)], 1u);
    return b;
}
__device__ __forceinline__ void xcd_barrier_complete(unsigned* bar, unsigned x, unsigned& nloc, unsigned& nx) {
    const unsigned G = gridDim.x * gridDim.y * gridDim.z;
    unsigned sum, cnt, mine, sp = 0u;
    for (;;) {
        sum = 0u; cnt = 0u; mine = 0u;
#pragma unroll
        for (unsigned j = 0; j < 16; ++j) { const unsigned c = xb_ld(&bar[XB_XCNT(j)]); sum += c; cnt += (c > 0u) ? 1u : 0u; mine = (j == x) ? c : mine; }
        if (sum == G) break;
        __builtin_amdgcn_s_sleep(1);
        if ((++sp & 255u) == 0u) { if (xb_ld(&bar[XB_TMO])) break; if (sp > XB_SPIN_CAP) { atomicAdd(&bar[XB_TMO], 1u); break; } }
    }
    nloc = mine > 0u ? mine : 1u; nx = cnt > 0u ? cnt : 1u;
}

__device__ __forceinline__ void xcd_barrier(const XcdBarrier& b) {
    asm volatile("s_waitcnt vmcnt(0)" ::: "memory");
    __syncthreads();
    if (threadIdx.x == 0) {
        unsigned* bar = b.bar;
        __builtin_amdgcn_s_waitcnt(0);
        unsigned nloc = b.st[0], nx = b.st[1];
        if (nloc == 0u) { xcd_barrier_complete(bar, b.x, nloc, nx); b.st[0] = nloc; b.st[1] = nx; }
        const unsigned old = xb_add(&bar[XB_XSUB(b.x)], 1u);
        const unsigned gen = old / nloc;
        if (old + 1u == (gen + 1u) * nloc) {
            __builtin_amdgcn_fence(__ATOMIC_RELEASE, "agent");
            asm volatile("s_waitcnt vmcnt(0)" ::: "memory");
            const unsigned og = xb_add(&bar[XB_TOP], 1u);
            const unsigned tg = og / nx;
            if (og + 1u == (tg + 1u) * nx) xb_add(&bar[XB_TOPGEN], 1u);
            else XB_SPIN(xb_ld(&bar[XB_TOPGEN]) == tg, bar);
            __builtin_amdgcn_fence(__ATOMIC_ACQUIRE, "agent");
            xb_add(&bar[XB_XGEN(b.x)], 1u);
            asm volatile("s_waitcnt vmcnt(0)" ::: "memory");
        } else {
            XB_SPIN(xb_ld(&bar[XB_XGEN(b.x)]) == gen, bar);
            __builtin_amdgcn_fence(__ATOMIC_ACQUIRE, "agent");
            asm volatile("s_waitcnt vmcnt(0)" ::: "memory");
        }
    }
    __syncthreads();
}

__device__ __forceinline__ int mixa_row(int L0) { const int w = L0 >> 10, ch = L0 & 1023; return w == 0 ? 2048 + ch : 256 * (ch >> 7) + 128 * (w - 1) + (ch & 127); }
__device__ __forceinline__ int map_row(int kind, int n) { const int n0 = n & ~31; return (kind == 0 ? n0 : kind == 2 ? ffnup_row(n0) : kind == 3 ? mixa_row(n0) : headperm_row(n0)) + (n & 31); }
__device__ __forceinline__ void tr_item128(const float* W, int ldw, int k0, int n0, const float* gain, bf16* WT, int Kd, int kind, int noff, LAS float* scr, int lane) {
    const int cl = 4 * (lane & 31), kh = lane >> 5;
    f32x4 v[16];
#pragma unroll
    for (int i = 0; i < 16; ++i) v[i] = *(const f32x4*)(W + (size_t)(k0 + 2 * i + kh) * ldw + n0 + cl);
#pragma unroll
    for (int i = 0; i < 16; ++i) { f32x4 t = v[i]; if (gain) t = t * gain[k0 + 2 * i + kh]; *(LAS f32x4*)(scr + (2 * i + kh) * 132 + cl) = t; }
    LDS_WAIT(); asm volatile("" ::: "memory");
    const int c = lane & 3;
#pragma unroll
    for (int j = 0; j < 8; ++j) { const int n = (lane >> 2) + 16 * j; const LAS float* s = scr + (8 * c) * 132 + n;
        v4u o; o.x = pk2(s[0 * 132], s[1 * 132]); o.y = pk2(s[2 * 132], s[3 * 132]); o.z = pk2(s[4 * 132], s[5 * 132]); o.w = pk2(s[6 * 132], s[7 * 132]);
        *(v4u*)(WT + (size_t)map_row(kind, noff + n0 + n) * Kd + k0 + 8 * c) = o; }
    LDS_WAIT(); asm volatile("" ::: "memory");
}

struct Args { const float* in[16]; float* out; unsigned char* ws; int ph_lo, ph_hi; };

__global__ void __launch_bounds__(NTHREADS, 2) yoco_fwd(Args args) {
    extern __shared__ __attribute__((aligned(16))) unsigned char lds[];
    cg::grid_group grid = cg::this_grid();
    LAS unsigned char* ldsl = (LAS unsigned char*)lds;
    const int tid0 = threadIdx.x, wave = __builtin_amdgcn_readfirstlane(tid0 >> 6);
    const int G = gridDim.x, bx = blockIdx.x, vcu = (G % 8 == 0) ? (bx % 8) * (G / 8) + bx / 8 : bx;
    const int gw = vcu * NWAVES + wave, NGW = G * NWAVES;
    typedef __attribute__((address_space(4))) const unsigned char* kptr_t;
    const kptr_t kargs = (kptr_t)__builtin_amdgcn_kernarg_segment_ptr();
#define ARG_IN(i) (*(const float* const volatile __attribute__((address_space(4)))*)(kargs + 8 * (i)))
#define ARG_OUT (*(float* const volatile __attribute__((address_space(4)))*)(kargs + 128))
#define ARG_WS (*(unsigned char* const volatile __attribute__((address_space(4)))*)(kargs + 136))
#define x_in ARG_IN(0)
#define attn_norm ARG_IN(1)
#define ffn_norm ARG_IN(2)
#define a_w_in ARG_IN(3)
#define a_conv ARG_IN(4)
#define a_w_out ARG_IN(5)
#define kv_norm ARG_IN(6)
#define w_kvf ARG_IN(7)
#define b_f ARG_IN(8)
#define k_norm ARG_IN(9)
#define b_w_qg ARG_IN(10)
#define q_norm ARG_IN(11)
#define b_w_out ARG_IN(12)
#define ffn_w_up ARG_IN(13)
#define ffn_conv ARG_IN(14)
#define ffn_w_down ARG_IN(15)
#define PTRS() int tid; asm volatile("v_mbcnt_lo_u32_b32 %0, -1, 0\n\tv_mbcnt_hi_u32_b32 %0, -1, %0" : "=v"(tid)); tid += wave * 64; const int lane = tid & 63; (void)lane; unsigned char* const ws = ARG_WS; float* const X = ARG_OUT; float* const SSQ = (float*)(ws + WS_CT); \
    bf16* const WF = (bf16*)(ws + WS_WF); bf16* const XB = (bf16*)(ws + WS_XB); bf16* const KB = (bf16*)(ws + WS_K); bf16* const VB = (bf16*)(ws + WS_V); bf16* const GB = KB; \
    bf16* const QO = (bf16*)(ws + WS_ACT); bf16* const SG = (bf16*)(ws + WS_SG); bf16* const HB = (bf16*)(ws + WS_ACT); bf16* const PROJ = (bf16*)(ws + WS_ACT); \
    float* const EDGEA = (float*)(ws + WS_EDGEA); float* const EDGEG = (float*)(ws + WS_EDGEG); float* const FLT = (float*)(ws + WS_FLT); float* const CT = (float*)(ws + WS_CT); \
    (void)X; (void)SSQ; (void)WF; (void)XB; (void)KB; (void)VB; (void)GB; (void)QO; (void)SG; (void)HB; (void)PROJ; (void)EDGEA; (void)EDGEG; (void)FLT; (void)CT;
    const int lo = args.ph_lo, hi = args.ph_hi; int ph = 0;
#define ON() (lo <= ph && ph < hi)
    volatile LAS unsigned* const bst = (volatile LAS unsigned*)(ldsl + LDS_BARST);
    if (tid0 < 2) bst[tid0] = 0u;
    __syncthreads();
#define SEAM() do { if (lo <= ph && ph + 1 < hi) { if (ph == 0) { grid.sync(); (void)xcd_barrier_post((unsigned*)(ARG_WS + WS_CTL), bst); } else { XcdBarrier xb_; xb_.bar = (unsigned*)(ARG_WS + WS_CTL); xb_.x = xb_xcc_id(); xb_.st = bst; xcd_barrier(xb_); } } ++ph; } while (0)

    if (ON()) { PTRS();
        if (bx == 0) for (int i = tid; i < (int)(CTL_BYTES / 4); i += NTHREADS) ((unsigned*)(ws + WS_CTL))[i] = 0u;
#pragma nounroll
      for (int rp = 0; rp < ((PROBE_X & 16) ? 2 : 1); ++rp) {
        LAS float* scr = (LAS float*)(ldsl + wave * 16896);
        constexpr int NITEMS = 2 * 768 + 2 * 256 + 512 + 512 + 16 + 512 + 2 * 256 + 4 * 1408 + 4 * 704;
        for (int it = gw; it < NITEMS; it += NGW) {
            int r = it;
            if (r < 1536) { const int l = r / 768; r %= 768; const int kb = r / 24, nb = r % 24;
                tr_item128(a_w_in + (size_t)l * D * 3 * D, 3 * D, 32 * kb, 128 * nb, attn_norm + l * D, (bf16*)(ws + WS_WIN) + (size_t)l * 3 * D * D, D, 3, 0, scr, lane); continue; } r -= 1536;
            if (r < 512) { const int l = r / 256; r %= 256; const int kb = r / 8, nb = r % 8;
                tr_item128(a_w_out + (size_t)l * D * D, D, 32 * kb, 128 * nb, nullptr, (bf16*)(ws + WS_WOUT) + (size_t)l * D * D, D, 0, 0, scr, lane); continue; } r -= 512;
            if (r < 512) { const int kb = r / 16, nb = r % 16;
                tr_item128(b_w_qg, 2 * D, 32 * kb, 128 * nb, attn_norm + 2 * D, (bf16*)(ws + WS_WQGKV), D, 1, 0, scr, lane); continue; } r -= 512;
            if (r < 512) { const int kb = r / 16, nb = r % 16;
                tr_item128(w_kvf, 2 * D + H, 32 * kb, 128 * nb, kv_norm, (bf16*)(ws + WS_WQGKV), D, 1, 2048, scr, lane); continue; } r -= 512;
            if (r < 16) { tr_item(w_kvf, 2 * D + H, 64 * r, 2 * D, kv_norm, WF, D, 0, 16, scr, lane); continue; } r -= 16;
            if (r < 512) { const int kb = r / 16, nb = r % 16;
                tr_item128(b_w_qg + (size_t)D * 2 * D, 2 * D, 32 * kb, 128 * nb, attn_norm + 3 * D, (bf16*)(ws + WS_WQG3), D, 1, 0, scr, lane); continue; } r -= 512;
            if (r < 512) { const int l = r / 256; r %= 256; const int kb = r / 8, nb = r % 8;
                tr_item128(b_w_out + (size_t)l * D * D, D, 32 * kb, 128 * nb, nullptr, (bf16*)(ws + WS_WBO) + (size_t)l * D * D, D, 0, 0, scr, lane); continue; } r -= 512;
            if (r < 4 * 1408) { const int l = r / 1408; r %= 1408; const int kb = r / 44, nb = r % 44;
                tr_item128(ffn_w_up + (size_t)l * D * 2 * FF, 2 * FF, 32 * kb, 128 * nb, ffn_norm + l * D, (bf16*)(ws + WS_WUP) + (size_t)l * 2 * FF * D, D, 2, 0, scr, lane); continue; } r -= 4 * 1408;
            { const int l = r / 704; r %= 704; const int kb = r / 8, nb = r % 8;
                tr_item128(ffn_w_down + (size_t)l * FF * D, D, 32 * kb, 128 * nb, nullptr, (bf16*)(ws + WS_WDN) + (size_t)l * D * FF, FF, 0, 0, scr, lane); }
        }
        for (int m = gw; m < M; m += NGW) {
            const f32x4* xr = (const f32x4*)(x_in + (size_t)m * D) + lane; f32x4 v[4]; float s = 0.f;
#pragma unroll
            for (int j = 0; j < 4; ++j) { v[j] = xr[64 * j]; s += (v[j].x * v[j].x + v[j].y * v[j].y) + (v[j].z * v[j].z + v[j].w * v[j].w); }
            s = wave_sum(s);
            v2u* o8 = (v2u*)(XB + (size_t)m * D) + lane;
#pragma unroll
            for (int j = 0; j < 4; ++j) { v2u o; o.x = pk2(v[j].x, v[j].y); o.y = pk2(v[j].z, v[j].w); o8[64 * j] = o; }
            if (lane < 4) SSQ[(size_t)m * 4 + lane] = lane == 0 ? s : 0.f;
        }
      }
    }
    SEAM();

#pragma nounroll
    for (int l = 0; l < 4; ++l) {
#pragma nounroll
        for (int half = 0; half < 2; ++half) {
            if (half == 0) {
                if (l < 2) {
                    if (ON()) { PTRS(); const float* ssq_in = SSQ; pg8::Gemm g{XB, (const bf16*)(ws + WS_WIN) + (size_t)l * 3 * D * D, M, 3 * D, D}; pg8::StaticOrder S; S.init(M, 3 * D, G, bx, (PROBE_X & 4) ? 2 : 1);
                        pg8::EpiMixA E{PROJ, PROJ + (size_t)M * D, ssq_in};
                        pg8::gemm_phase<pg8::EpiMixA, pg8::StaticOrder, true, true>(ldsl, g, S, E, tid); }
                    SEAM();
                    if (ON()) { PTRS();
                        const float* cw = a_conv + (size_t)l * 3 * D; const bf16* Bo = PROJ; const bf16* CHp = PROJ + (size_t)M * D;
                        for (int item = vcu * NTHREADS + tid; item < (M / 32) * 128; item += G * NTHREADS) {
                            const int cgp = item & 127, r0 = (item >> 7) * 32, c0 = 8 * cgp;
                            float w0[8], w1[8], w2[8], p1[8], p2[8];
#pragma unroll
                            for (int e = 0; e < 8; ++e) { w0[e] = cw[c0 + e]; w1[e] = cw[D + c0 + e]; w2[e] = cw[2 * D + c0 + e]; p1[e] = 0.f; p2[e] = 0.f; }
                            if ((r0 & (T - 1)) != 0) {
                                const v4u c2 = *(const v4u*)(CHp + (size_t)(r0 - 2) * D + c0), c1 = *(const v4u*)(CHp + (size_t)(r0 - 1) * D + c0);
#pragma unroll
                                for (int k = 0; k < 4; ++k) { p2[2 * k] = bflo(c2[k]); p2[2 * k + 1] = bfhi(c2[k]); p1[2 * k] = bflo(c1[k]); p1[2 * k + 1] = bfhi(c1[k]); }
                            }
#pragma nounroll
                            for (int r = r0; r < r0 + 32; r += 4) {
                                v4u bb[4], cc[4];
#pragma unroll
                                for (int i = 0; i < 4; ++i) { bb[i] = *(const v4u*)(Bo + (size_t)(r + i) * D + c0); cc[i] = *(const v4u*)(CHp + (size_t)(r + i) * D + c0); }
#pragma unroll
                                for (int i = 0; i < 4; ++i) {
                                    float ch[8], o[8];
#pragma unroll
                                    for (int k = 0; k < 4; ++k) { ch[2 * k] = bflo(cc[i][k]); ch[2 * k + 1] = bfhi(cc[i][k]); }
#pragma unroll
                                    for (int e = 0; e < 8; ++e) { const float u = w0[e] * p2[e] + w1[e] * p1[e] + w2[e] * ch[e]; p2[e] = p1[e]; p1[e] = ch[e]; o[e] = u; }
                                    v4u ov;
#pragma unroll
                                    for (int k = 0; k < 4; ++k) ov[k] = pk2(bflo(bb[i][k]) * o[2 * k], bfhi(bb[i][k]) * o[2 * k + 1]);
                                    *(v4u*)(GB + (size_t)(r + i) * D + c0) = ov;
                                }
                            }
                        }
                    }
                    SEAM();
                } else {
                    if (ON()) { PTRS(); const float* ssq_in = SSQ;
                        const int j = l - 2, N = (l == 2) ? 4 * D : 2 * D;
                        pg8::Gemm g{XB, (const bf16*)(ws + (l == 2 ? WS_WQGKV : WS_WQG3)), M, N, D}; pg8::StaticOrder S; S.init(M, N, G, bx, (PROBE_X & 4) ? 2 : 1);
                        pg8::EpiQG E{QO, SG, KB, VB, ssq_in, q_norm + j * HD, k_norm, attn_body::C2};
                        pg8::gemm_phase<pg8::EpiQG, pg8::StaticOrder, true, true>(ldsl, g, S, E, tid);
                        if (l == 2) {
                            for (int rg = gw; rg < M / 16; rg += NGW) {
                                f32x4 acc = (f32x4){0.f, 0.f, 0.f, 0.f};
                                const bf16* wp = WF + (size_t)(lane & 15) * D + 8 * (lane >> 4); const bf16* xp = XB + (size_t)(16 * rg + (lane & 15)) * D + 8 * (lane >> 4);
#pragma unroll 8
                                for (int kt = 0; kt < 32; ++kt) { const bf16x8 wa = *(const bf16x8*)(wp + 32 * kt), xa = *(const bf16x8*)(xp + 32 * kt); acc = __builtin_amdgcn_mfma_f32_16x16x32_bf16(wa, xa, acc, 0, 0, 0); }
                                const int row = 16 * rg + (lane & 15), bb = row / T, s = row % T; const float rs = pg8::rstd_of(ssq_in, row);
#pragma unroll
                                for (int e = 0; e < 4; ++e) { const int hd = 4 * (lane >> 4) + e; const float z = acc[e] * rs + b_f[hd];
                                    const float ls = fminf(z, 0.f) - log1pf(expf(-fabsf(z))); FLT[(size_t)(bb * H + hd) * T + s] = ls; }
                            }
                        }
                    }
                    SEAM();
                    if (l == 2) {
                        if (ON()) { PTRS();
                            for (int bh = vcu; bh < BATCH * H; bh += G) {
                                const f32x4* src = (const f32x4*)(FLT + (size_t)bh * T + 16 * tid); f32x4 v[4]; float run = 0.f;
#pragma unroll
                                for (int q = 0; q < 4; ++q) { v[q] = src[q]; v[q].x += run; v[q].y += v[q].x; v[q].z += v[q].y; v[q].w += v[q].z; run = v[q].w; }
                                float inc = run;
#pragma unroll
                                for (int o = 1; o < 64; o <<= 1) { const float t = __shfl_up(inc, o); if (lane >= o) inc += t; }
                                LAS float* wsum = (LAS float*)ldsl;
                                __syncthreads();
                                if (lane == 63) wsum[wave] = inc;
                                __syncthreads();
                                float off = inc - run;
                                for (int w = 0; w < wave; ++w) off += wsum[w];
                                LAS float* cl = (LAS float*)(ldsl + 1024);
                                v2u* kxg = (v2u*)(X) + (size_t)bh * T + 16 * tid;
#pragma unroll
                                for (int q = 0; q < 4; ++q) { const f32x4 c4 = (v[q] + off) * 1.4426950408889634f; *(LAS f32x4*)(cl + 16 * tid + 4 * q) = c4;
#pragma unroll
                                    for (int e = 0; e < 4; ++e) { const float bb = -c4[e]; const unsigned h_ = f2bf(bb); const float r1 = bb - __builtin_bit_cast(float, h_ << 16);
                                        const unsigned m_ = f2bf(r1); const float r2 = r1 - __builtin_bit_cast(float, m_ << 16); v2u w; w.x = h_ | (m_ << 16); w.y = f2bf(r2) | 0x3f800000u; kxg[4 * q + e] = w; } }
                                __syncthreads();
                                float gk = fabsf(k_norm[lane]), gq0 = fabsf(q_norm[lane]), gq1 = fabsf(q_norm[HD + lane]);
#pragma unroll
                                for (int o = 1; o < 64; o <<= 1) { gk = fmaxf(gk, __shfl_xor(gk, o)); gq0 = fmaxf(gq0, __shfl_xor(gq0, o)); gq1 = fmaxf(gq1, __shfl_xor(gq1, o)); }
                                const int qb = tid >> 4, jj = tid & 15, NT0 = 4 * qb + 4; const float cq = cl[256 * qb];
#pragma unroll
                                for (int ly = 0; ly < 2; ++ly) {
                                    const float TH = 2.0f * (8.0f * (ly == 0 ? gq0 : gq1) * gk * 1.4426950408889634f * 1.05f) + 160.0f;
                                    int j0 = NT0 - 4;
                                    for (int j = jj; j < NT0; j += 16) if (cq - cl[64 * j + 63] >= -TH) { j0 = min(j0, j); break; }
#pragma unroll
                                    for (int o = 1; o < 16; o <<= 1) j0 = min(j0, __shfl_xor(j0, o));
                                    if (jj == 0) ((unsigned*)(X + 2 * 1024 * 1024))[(ly * BATCH * H + bh) * 32 + qb] = (unsigned)(j0 & ~1);
                                }
                                __syncthreads();
                            }
                        }
                        SEAM();
                    }
                    if (ON()) { PTRS();
                        float gq = fabsf(q_norm[(l - 2) * HD + lane]), gk = fabsf(k_norm[lane]);
#pragma unroll
                        for (int o = 1; o < 64; o <<= 1) { gq = fmaxf(gq, __shfl_xor(gq, o)); gk = fmaxf(gk, __shfl_xor(gk, o)); }
                        const float BND = 8.0f * gq * gk * 1.4426950408889634f * 1.05f;
#pragma nounroll
                        for (int rp = 0; rp < ((PROBE_X & 2) ? 2 : 1); ++rp) {
                            const attn_body::AttnTensors AT{(const attn_body::bf16*)QO, (const attn_body::bf16*)KB, (const attn_body::bf16*)VB, (attn_body::bf16*)(((PROBE_X & 2) && rp == 0) ? ws + WS_ACT + 128 * MiB : ws + WS_ACT), (const attn_body::bf16*)SG, (const unsigned*)X, (const unsigned*)(X + 2 * 1024 * 1024) + (l - 2) * BATCH * H * 32};
                            unsigned* const qctr = (unsigned*)(ws + WS_CTL) + 3584 + 64 * (l - 2) + 128 * rp;
                            attn_body::attn_phase<40>((char*)lds, AT, qctr, BND, tid, (PROBE_X & 32) && rp == 0); __syncthreads(); }
                    }
                    SEAM();
                }
            } else {
                if (ON()) { PTRS(); const float* ssq_in = SSQ; pg8::Gemm g{XB, (const bf16*)(ws + WS_WUP) + (size_t)l * 2 * FF * D, M, 2 * FF, D}; pg8::StaticOrder S; S.init(M, 2 * FF, G, bx, (PROBE_X & 1) ? 2 : 1);
                    pg8::EpiFfnUp E{HB, ssq_in, ffn_conv + (size_t)l * 3 * FF, EDGEA, EDGEG};
pg8::gemm_phase<pg8::EpiFfnUp, pg8::StaticOrder, true, true>(ldsl, g, S, E, tid); }
                SEAM();
            }
            if (ON()) { PTRS(); float* ssq_out = SSQ;
                const bf16* A = half == 1 ? HB : (l < 2 ? GB : QO);
                const bf16* Bt = half == 1 ? (const bf16*)(ws + WS_WDN) + (size_t)l * D * FF : (l < 2 ? (const bf16*)(ws + WS_WOUT) + (size_t)l * D * D : (const bf16*)(ws + WS_WBO) + (size_t)(l - 2) * D * D);
                pg8::Gemm g{A, Bt, M, D, half == 1 ? FF : D}; pg8::StaticOrder S; S.init(M, D, G, bx, (PROBE_X & 8) ? 2 : 1);
                if (half == 1) {
                    const float* cw = ffn_conv + (size_t)l * 3 * FF; pg8::Unit uu;
                    for (int ui = 0; S.next(ui, uu); ++ui) {
                        for (int item = tid; item < 4 * (FF / 4); item += NTHREADS) {
                            const int grp = 4 * uu.pm + item / (FF / 4), ch = 4 * (item % (FF / 4)); const bool first = ((grp * 64) & (T - 1)) == 0;
                            const f32x4 z4 = (f32x4){0.f, 0.f, 0.f, 0.f};
                            const f32x4 a0 = *(const f32x4*)(EDGEA + ((size_t)grp * 4 + 0) * FF + ch), a1 = *(const f32x4*)(EDGEA + ((size_t)grp * 4 + 1) * FF + ch);
                            const f32x4 pm2 = first ? z4 : *(const f32x4*)(EDGEA + ((size_t)(grp - 1) * 4 + 2) * FF + ch), pm1 = first ? z4 : *(const f32x4*)(EDGEA + ((size_t)(grp - 1) * 4 + 3) * FF + ch);
                            const f32x4 g0 = *(const f32x4*)(EDGEG + ((size_t)grp * 2 + 0) * FF + ch), g1 = *(const f32x4*)(EDGEG + ((size_t)grp * 2 + 1) * FF + ch);
                            const f32x4 w0 = *(const f32x4*)(cw + ch), w1 = *(const f32x4*)(cw + FF + ch), w2 = *(const f32x4*)(cw + 2 * FF + ch);
                            const f32x4 c0 = w0 * pm2 + w1 * pm1 + w2 * a0, c1 = w0 * pm1 + w1 * a0 + w2 * a1; f32x4 h0, h1;
#pragma unroll
                            for (int e = 0; e < 4; ++e) { h0[e] = c0[e] * pg8::sigmoidf_fast(c0[e]) * g0[e]; h1[e] = c1[e] * pg8::sigmoidf_fast(c1[e]) * g1[e]; }
                            v2u o0, o1; o0.x = pk2(h0[0], h0[1]); o0.y = pk2(h0[2], h0[3]); o1.x = pk2(h1[0], h1[1]); o1.y = pk2(h1[2], h1[3]);
                            *(v2u*)(HB + (size_t)(grp * 64) * FF + ch) = o0; *(v2u*)(HB + (size_t)(grp * 64 + 1) * FF + ch) = o1;
                        }
                    }
                    asm volatile("s_waitcnt vmcnt(0)" ::: "memory"); __syncthreads();
                }
pg8::EpiRes E{(l == 0 && half == 0) ? x_in : (const float*)nullptr, (l == 3 && half == 1) ? X : (float*)nullptr, XB, ssq_out, (LAS float*)(ldsl + RING_BYTES), (PROBE_X & 8) ? 2 : 1};
                pg8::gemm_phase<pg8::EpiRes, pg8::StaticOrder, true, true>(ldsl, g, S, E, tid);
            }
            SEAM();
        }
    }
#undef ON
#undef SEAM
#undef PTRS
#undef x_in
#undef attn_norm
#undef ffn_norm
#undef a_w_in
#undef a_conv
#undef a_w_out
#undef kv_norm
#undef w_kvf
#undef b_f
#undef k_norm
#undef b_w_qg
#undef q_norm
#undef b_w_out
#undef ffn_w_up
#undef ffn_conv
#undef ffn_w_down
}

extern "C" void kernel_launch(void* const* d_in, const int* in_sizes, int n_in, void* d_out, int out_size, void* d_ws, size_t ws_size, hipStream_t stream) {
    static int grid = 0;
    if (grid == 0) {
        if (n_in != 16 || in_sizes[0] != M * D || out_size != M * D || ws_size < WS_END) { fprintf(stderr, "kernel_launch: unexpected shapes: n_in %d in0 %d out %d ws %zu (need %zu)\n", n_in, n_in > 0 ? in_sizes[0] : -1, out_size, ws_size, (size_t)WS_END); grid = -1; return; }
        int dev = 0, cus = 0, per_cu = 0;
        if (hipGetDevice(&dev) != hipSuccess || hipDeviceGetAttribute(&cus, hipDeviceAttributeMultiprocessorCount, dev) != hipSuccess) { grid = -1; return; }
        if (hipFuncSetAttribute((const void*)yoco_fwd, hipFuncAttributeMaxDynamicSharedMemorySize, LDS_BYTES) != hipSuccess) { fprintf(stderr, "kernel_launch: hipFuncSetAttribute failed\n"); grid = -1; return; }
        if (hipOccupancyMaxActiveBlocksPerMultiprocessor(&per_cu, (const void*)yoco_fwd, NTHREADS, LDS_BYTES) != hipSuccess || per_cu < 1) { fprintf(stderr, "kernel_launch: occupancy query says %d blocks per CU\n", per_cu); per_cu = 1; }
        (void)hipGetLastError();
        grid = cus * per_cu;
        fprintf(stderr, "kernel_launch: grid %d (%d CUs x %d)\n", grid, cus, per_cu);
    }
    if (grid < 0) return;
#if MK_MULTI
    if (hipMemsetAsync((char*)d_ws + WS_CTL, 0, CTL_BYTES, stream) != hipSuccess) { fprintf(stderr, "kernel_launch: memset failed\n"); return; }
#endif
    Args a{};
    for (int i = 0; i < 16; ++i) a.in[i] = (const float*)d_in[i];
    a.out = (float*)d_out; a.ws = (unsigned char*)d_ws;
#if MK_MULTI
    for (int p = 0; p < N_PHASES; ++p) { a.ph_lo = p; a.ph_hi = p + 1; hipLaunchKernelGGL(yoco_fwd, dim3(grid), dim3(NTHREADS), LDS_BYTES, stream, a); }
#else
    a.ph_lo = 0; a.ph_hi = N_PHASES;
    void* kargs[] = {&a};
    const hipError_t e = hipLaunchCooperativeKernel((const void*)yoco_fwd, dim3(grid), dim3(NTHREADS), kargs, LDS_BYTES, stream);
    if (e != hipSuccess) fprintf(stderr, "kernel_launch: cooperative launch failed: %s (grid %d)\n", hipGetErrorString(e), grid);
#endif
}
```

```cpp
#include <hip/hip_runtime.h>
#include <cstdio>
#include <cstdint>
#include <hip/hip_cooperative_groups.h>
namespace pg8 {
#define PG8_LAS __attribute__((address_space(3)))
typedef unsigned short bf16_t;
typedef short bf16x8 __attribute__((ext_vector_type(8)));
typedef float f32x4 __attribute__((ext_vector_type(4)));
typedef unsigned u32x4 __attribute__((ext_vector_type(4)));
constexpr int BM = 256, BK = 64, HALF = 128, HTB = HALF * BK * 2  , STAGE_BYTES = 8 * HTB, NXCD = 8, WGM = 4;

__host__ __device__ __forceinline__ int lds_byte(int r, int c) { const int st = (r >> 4) * 2 + (c >> 5), rr = r & 15, cc = c & 31, ob = rr * 64 + cc * 2; return st * 1024 + (ob ^ (((ob >> 9) & 1) << 5)); }
__host__ __device__ __forceinline__ void stage_rc(int b, int& R, int& C) { const int st = b / 1024, sb = b % 1024, swz = sb ^ (((sb >> 9) & 1) << 5); R = (st >> 1) * 16 + swz / 64; C = (st & 1) * 32 + (swz % 64) / 2; }
__host__ __device__ __forceinline__ int perm32(int rho) { const int n = rho >> 4, i = rho & 15; return 8 * (i >> 2) + 4 * n + (i & 3); }

struct Unit { int pm, pn, rp; };
struct Gemm { const bf16_t* A; const bf16_t* Bt; int M, N, K; };

struct StaticOrder {
    int nM, nN, nwg, G, c, rep;
    __host__ __device__ void init(int M, int N, int G_, int c_, int rep_ = 1) { nM = M / BM; nN = N / BM; nwg = nM * nN; G = G_; c = c_; rep = rep_; }
    __host__ __device__ bool next(int i, Unit& u) const {
        const long L = (long)(i / rep) * G + c; if (L >= nwg) return false;
        int wgid = (int)L; { const int q = nwg / NXCD, r = nwg % NXCD, xcd = wgid % NXCD, off = wgid / NXCD; wgid = (xcd < r ? xcd * (q + 1) : r * (q + 1) + (xcd - r) * q) + off; }
        const int nig = WGM * nN, gid = wgid / nig, fm = gid * WGM, gsz = (nM - fm) < WGM ? (nM - fm) : WGM;
        u.pm = fm + ((wgid % nig) % gsz); u.pn = (wgid % nig) / gsz; u.rp = i % rep; return true;
    }
    __device__ __forceinline__ void a_ready(const Unit&) const {}
    __device__ __forceinline__ void done(const Unit&) const {}
};

__device__ __forceinline__ unsigned cvt_pk_bf16(float lo, float hi) { unsigned r; asm volatile("v_cvt_pk_bf16_f32 %0, %1, %2" : "=v"(r) : "v"(lo), "v"(hi)); return r; }
typedef float f32x2 __attribute__((ext_vector_type(2)));
__device__ __forceinline__ f32x2 gelu_pk(f32x2 v) {
    const f32x2 av = __builtin_elementwise_abs(v), d = av * 0.2316418882f + 1.0f;
    f32x2 t; t.x = __builtin_amdgcn_rcpf(d.x); t.y = __builtin_amdgcn_rcpf(d.y);
    f32x2 q = t * 0.5307027145f + (-0.7265760135f); q = q * t + 0.7107068705f; q = q * t + (-0.142248368f); q = q * t + 0.127414796f; q = q * t;
    const f32x2 s = (v * v) * (-0.72134752044f);
    f32x2 e; e.x = __builtin_amdgcn_exp2f(s.x); e.y = __builtin_amdgcn_exp2f(s.y);
    const f32x2 m = v * (q * e), r = v - m;
    f32x2 o; o.x = v.x < 0.f ? m.x : r.x; o.y = v.y < 0.f ? m.y : r.y; return o;
}

template <int ACT  > struct EpiBf16 {
    static constexpr bool PERM = true, AFTER_DRAIN = false; static_assert(ACT == 0 || ACT == 1, "EpiBf16: ACT is 0 (none) or 1 (gelu_pk)");
    bf16_t* O; int ldc; const float* bias; int split_cols; size_t split_stride; float scale0;
    __device__ __forceinline__ void operator()(const f32x4 (&acc)[2][2][4][2], const Unit& u, int wr, int wc, int fr_, int fq_) const {
        int fr = fr_, fq = fq_; asm volatile("" : "+v"(fr), "+v"(fq));
        const int row0 = u.pm * BM + wr * 64 + fr; int colt = u.pn * BM; bf16_t* base = O;
        float sc = 1.f; if (split_cols) { const int t = colt / split_cols; base += (size_t)t * split_stride; colt -= t * split_cols; if (t == 0) sc = scale0; }
        const int col0 = colt + wc * 32 + 8 * fq, bcol0 = u.pn * BM + wc * 32 + 8 * fq;
        f32x4 bv[2][2];
#pragma unroll
        for (int bj = 0; bj < 2; ++bj)
#pragma unroll
            for (int n = 0; n < 2; ++n) bv[bj][n] = bias ? *(const f32x4*)(bias + bcol0 + bj * HALF + 4 * n) : (f32x4){0.f, 0.f, 0.f, 0.f};
#pragma unroll
        for (int ai = 0; ai < 2; ++ai)
#pragma unroll
            for (int m = 0; m < 4; ++m) { bf16_t* rowp = base + (size_t)(row0 + ai * HALF + m * 16) * ldc + col0;
#pragma unroll
                for (int bj = 0; bj < 2; ++bj) { f32x4 v0 = acc[ai][bj][m][0] + bv[bj][0], v1 = acc[ai][bj][m][1] + bv[bj][1];
                    if (ACT == 1) { f32x2 a = gelu_pk((f32x2){v0[0], v0[1]}), b = gelu_pk((f32x2){v0[2], v0[3]}), c = gelu_pk((f32x2){v1[0], v1[1]}), d = gelu_pk((f32x2){v1[2], v1[3]});
                        v0 = (f32x4){a.x, a.y, b.x, b.y}; v1 = (f32x4){c.x, c.y, d.x, d.y}; }
                    v0 = v0 * sc; v1 = v1 * sc; u32x4 w; w.x = cvt_pk_bf16(v0[0], v0[1]); w.y = cvt_pk_bf16(v0[2], v0[3]); w.z = cvt_pk_bf16(v1[0], v1[1]); w.w = cvt_pk_bf16(v1[2], v1[3]);
                    *(u32x4*)(rowp + bj * HALF) = w; } }
    }
};
__device__ __forceinline__ float rstd_of(const float* ssq, int row) { const f32x4 a = *(const f32x4*)(ssq + (size_t)row * 4); return __builtin_amdgcn_rsqf(((a[0] + a[1]) + (a[2] + a[3])) * (1.0f / 1024.0f) + 1e-6f); }
__device__ __forceinline__ float ror1f(float v) { return __builtin_bit_cast(float, __builtin_amdgcn_mov_dpp(__builtin_bit_cast(int, v), 0x121, 0xf, 0xf, false)); }
__device__ __forceinline__ float ror2f(float v) { return __builtin_bit_cast(float, __builtin_amdgcn_mov_dpp(__builtin_bit_cast(int, v), 0x122, 0xf, 0xf, false)); }
__device__ __forceinline__ float sigmoidf_fast(float v) { return __builtin_amdgcn_rcpf(1.0f + __builtin_amdgcn_exp2f(v * -1.4426950408889634f)); }

struct EpiScaleBf16 {
    static constexpr bool PERM = true, AFTER_DRAIN = false;
    bf16_t* O; int ldc; const float* ssq;
    __device__ __forceinline__ void operator()(const f32x4 (&acc)[2][2][4][2], const Unit& u, int wr, int wc, int fr_, int fq_) const {
        int fr = fr_, fq = fq_; asm volatile("" : "+v"(fr), "+v"(fq));
        const int row0 = u.pm * BM + wr * 64 + fr, col0 = u.pn * BM + wc * 32 + 8 * fq;
        float rsv[2][4];
#pragma unroll
        for (int ai = 0; ai < 2; ++ai)
#pragma unroll
            for (int m = 0; m < 4; ++m) rsv[ai][m] = rstd_of(ssq, row0 + ai * HALF + m * 16);
#pragma unroll
        for (int ai = 0; ai < 2; ++ai)
#pragma unroll
            for (int m = 0; m < 4; ++m) { const int row = row0 + ai * HALF + m * 16; const float rs = rsv[ai][m]; bf16_t* rowp = O + (size_t)row * ldc + col0;
#pragma unroll
                for (int bj = 0; bj < 2; ++bj) { const f32x4 v0 = acc[ai][bj][m][0] * rs, v1 = acc[ai][bj][m][1] * rs;
                    u32x4 w; w.x = cvt_pk_bf16(v0[0], v0[1]); w.y = cvt_pk_bf16(v0[2], v0[3]); w.z = cvt_pk_bf16(v1[0], v1[1]); w.w = cvt_pk_bf16(v1[2], v1[3]);
                    *(u32x4*)(rowp + bj * HALF) = w; } }
    }
};
struct EpiMixA {
    static constexpr bool PERM = true, AFTER_DRAIN = false;
    bf16_t* Bo; bf16_t* CH; const float* ssq;
    __device__ __forceinline__ void operator()(const f32x4 (&acc)[2][2][4][2], const Unit& u, int wr, int wc, int fr_, int fq_) const {
        int fr = fr_, fq = fq_; asm volatile("" : "+v"(fr), "+v"(fq));
        const int row0 = u.pm * BM + wr * 64 + fr;
        float rsv[2][4];
#pragma unroll
        for (int ai = 0; ai < 2; ++ai)
#pragma unroll
            for (int m = 0; m < 4; ++m) rsv[ai][m] = rstd_of(ssq, row0 + ai * HALF + m * 16);
        if (u.pn < 8) {
            const int col0 = u.pn * 128 + wc * 32 + 8 * fq;
#pragma unroll
            for (int ai = 0; ai < 2; ++ai)
#pragma unroll
                for (int m = 0; m < 4; ++m) { const float rs2 = rsv[ai][m] * rsv[ai][m]; const f32x4 v0 = acc[ai][0][m][0] * acc[ai][1][m][0] * rs2, v1 = acc[ai][0][m][1] * acc[ai][1][m][1] * rs2;
                    u32x4 w; w.x = cvt_pk_bf16(v0[0], v0[1]); w.y = cvt_pk_bf16(v0[2], v0[3]); w.z = cvt_pk_bf16(v1[0], v1[1]); w.w = cvt_pk_bf16(v1[2], v1[3]);
                    *(u32x4*)(CH + (size_t)(row0 + ai * HALF + m * 16) * 1024 + col0) = w; }
        } else {
            const int col0 = (u.pn - 8) * BM + wc * 32 + 8 * fq;
#pragma unroll
            for (int ai = 0; ai < 2; ++ai)
#pragma unroll
                for (int m = 0; m < 4; ++m) { const float rs = rsv[ai][m]; bf16_t* rowp = Bo + (size_t)(row0 + ai * HALF + m * 16) * 1024 + col0;
#pragma unroll
                    for (int bj = 0; bj < 2; ++bj) { const f32x4 v0 = acc[ai][bj][m][0] * rs, v1 = acc[ai][bj][m][1] * rs;
                        u32x4 w; w.x = cvt_pk_bf16(v0[0], v0[1]); w.y = cvt_pk_bf16(v0[2], v0[3]); w.z = cvt_pk_bf16(v1[0], v1[1]); w.w = cvt_pk_bf16(v1[2], v1[3]);
                        *(u32x4*)(rowp + bj * HALF) = w; } }
        }
    }
};
struct EpiRes {
    static constexpr bool PERM = true, AFTER_DRAIN = false;
    const float* xin32; float* xout32; bf16_t* xb; float* ssq_out; PG8_LAS float* sq_lds; int nrep;
    __device__ __forceinline__ void operator()(const f32x4 (&acc)[2][2][4][2], const Unit& u, int wr, int wc, int fr_, int fq_) const {
        int fr = fr_, fq = fq_; asm volatile("" : "+v"(fr), "+v"(fq));
        const int row0 = u.pm * BM + wr * 64 + fr, col0 = u.pn * BM + wc * 32 + 8 * fq;
#pragma unroll
        for (int ai = 0; ai < 2; ++ai) {
            u32x4 xo[4][2];
            if (!(xin32 && u.rp == 0)) {
#pragma unroll
                for (int m = 0; m < 4; ++m)
#pragma unroll
                    for (int bj = 0; bj < 2; ++bj) xo[m][bj] = *(const u32x4*)(xb + (size_t)(row0 + ai * HALF + m * 16) * 1024 + col0 + bj * HALF);
            }
#pragma unroll
            for (int m = 0; m < 4; ++m) { const int row = row0 + ai * HALF + m * 16; const size_t off = (size_t)row * 1024 + col0; float s = 0.f;
#pragma unroll
                for (int bj = 0; bj < 2; ++bj) {
                    f32x4 x0, x1;
                    if (xin32 && u.rp == 0) { x0 = *(const f32x4*)(xin32 + off + bj * HALF); x1 = *(const f32x4*)(xin32 + off + bj * HALF + 4); }
                    else { const u32x4 o = xo[m][bj];
                        x0 = (f32x4){__builtin_bit_cast(float, o.x << 16), __builtin_bit_cast(float, o.x & 0xffff0000u), __builtin_bit_cast(float, o.y << 16), __builtin_bit_cast(float, o.y & 0xffff0000u)};
                        x1 = (f32x4){__builtin_bit_cast(float, o.z << 16), __builtin_bit_cast(float, o.z & 0xffff0000u), __builtin_bit_cast(float, o.w << 16), __builtin_bit_cast(float, o.w & 0xffff0000u)}; }
                    const float sc = nrep > 1 ? 1.0f / (float)nrep : 1.0f; const f32x4 v0 = x0 + acc[ai][bj][m][0] * sc, v1 = x1 + acc[ai][bj][m][1] * sc;
                    if (xout32) { *(f32x4*)(xout32 + off + bj * HALF) = v0; *(f32x4*)(xout32 + off + bj * HALF + 4) = v1; }
                    s += (v0[0] * v0[0] + v0[1] * v0[1]) + (v0[2] * v0[2] + v0[3] * v0[3]) + (v1[0] * v1[0] + v1[1] * v1[1]) + (v1[2] * v1[2] + v1[3] * v1[3]);
                    u32x4 w; w.x = cvt_pk_bf16(v0[0], v0[1]); w.y = cvt_pk_bf16(v0[2], v0[3]); w.z = cvt_pk_bf16(v1[0], v1[1]); w.w = cvt_pk_bf16(v1[2], v1[3]);
                    if (!xout32) *(u32x4*)(xb + off + bj * HALF) = w; }
                s += __shfl_xor(s, 16); s += __shfl_xor(s, 32);
                if (fq == 0) sq_lds[(ai * HALF + wr * 64 + m * 16 + fr) * 4 + wc] = s; }
        }
        asm volatile("s_waitcnt lgkmcnt(0)" ::: "memory"); __builtin_amdgcn_s_barrier(); asm volatile("" ::: "memory");
        const int t = (wr * 4 + wc) * 64 + fq * 16 + fr;
        if (t < 256 && u.rp == nrep - 1 && !xout32) { const f32x4 p4 = *(const PG8_LAS f32x4*)(sq_lds + t * 4); ssq_out[(size_t)(u.pm * BM + t) * 4 + u.pn] = (p4[0] + p4[1]) + (p4[2] + p4[3]); }
    }
};
struct EpiQG {
    static constexpr bool PERM = true, AFTER_DRAIN = false;
    bf16_t *Q, *SG, *Kb, *Vb; const float* ssq; const float* qn; const float* kn; float qscale;
    __device__ __forceinline__ void operator()(const f32x4 (&acc)[2][2][4][2], const Unit& u, int wr, int wc, int fr_, int fq_) const {
        int fr = fr_, fq = fq_; asm volatile("" : "+v"(fr), "+v"(fq));
        const int kind = u.pn >> 2;
        const int row0 = u.pm * BM + wr * 64 + fr, colb = (u.pn & 3) * 256 + wc * 64 + 8 * fq;
        bf16_t* dst = kind == 0 ? Q : kind == 1 ? SG : kind == 2 ? Kb : Vb;
        const float* gsrc = kind == 0 ? qn : kn; const bool nrm = (kind == 0 || kind == 2); const float osc = kind == 0 ? qscale : 1.0f;
        f32x4 g[2][2];
#pragma unroll
        for (int bj = 0; bj < 2; ++bj)
#pragma unroll
            for (int n = 0; n < 2; ++n) g[bj][n] = *(const f32x4*)(gsrc + 32 * bj + 8 * fq + 4 * n);
        float rsv[2][4];
#pragma unroll
        for (int ai = 0; ai < 2; ++ai)
#pragma unroll
            for (int m = 0; m < 4; ++m) rsv[ai][m] = rstd_of(ssq, row0 + ai * HALF + m * 16);
#pragma unroll
        for (int ai = 0; ai < 2; ++ai)
#pragma unroll
            for (int m = 0; m < 4; ++m) { const int row = row0 + ai * HALF + m * 16; const float rs = rsv[ai][m];
                f32x4 v[2][2]; float ss = 0.f;
#pragma unroll
                for (int bj = 0; bj < 2; ++bj)
#pragma unroll
                    for (int n = 0; n < 2; ++n) { v[bj][n] = acc[ai][bj][m][n] * rs; const f32x4 t = v[bj][n]; ss += (t[0] * t[0] + t[1] * t[1]) + (t[2] * t[2] + t[3] * t[3]); }
                if (nrm) { ss += __shfl_xor(ss, 16); ss += __shfl_xor(ss, 32); const float r = __builtin_amdgcn_rsqf(ss * (1.0f / 64.0f) + 1e-6f) * osc;
#pragma unroll
                    for (int bj = 0; bj < 2; ++bj)
#pragma unroll
                        for (int n = 0; n < 2; ++n) v[bj][n] = v[bj][n] * r * g[bj][n]; }
                else if (kind == 1) {
#pragma unroll
                    for (int bj = 0; bj < 2; ++bj)
#pragma unroll
                        for (int n = 0; n < 2; ++n)
#pragma unroll
                            for (int e = 0; e < 4; ++e) v[bj][n][e] = sigmoidf_fast(v[bj][n][e]); }
                bf16_t* rowp = dst + (size_t)row * 1024 + colb;
#pragma unroll
                for (int bj = 0; bj < 2; ++bj) { const f32x4 v0 = v[bj][0], v1 = v[bj][1];
                    u32x4 w; w.x = cvt_pk_bf16(v0[0], v0[1]); w.y = cvt_pk_bf16(v0[2], v0[3]); w.z = cvt_pk_bf16(v1[0], v1[1]); w.w = cvt_pk_bf16(v1[2], v1[3]);
                    *(u32x4*)(rowp + 32 * bj) = w; } }
    }
};
struct EpiFfnUp {
    static constexpr bool PERM = true, AFTER_DRAIN = false;
    bf16_t* Hh; const float* ssq; const float* cw; float* edgeA; float* edgeG;
    __device__ __forceinline__ void operator()(const f32x4 (&acc)[2][2][4][2], const Unit& u, int wr, int wc, int fr_, int fq_) const {
        int fr = fr_, fq = fq_; asm volatile("" : "+v"(fr), "+v"(fq));
        constexpr int FF = 2816; constexpr float L2E = 1.4426950408889634f, LN2 = 0.6931471805599453f;
        const int ch0 = u.pn * 128 + wc * 32 + 8 * fq;
        const bool ge1 = fr >= 1, ge2 = fr >= 2;
        float rsv[2][4];
#pragma unroll
        for (int ai = 0; ai < 2; ++ai)
#pragma unroll
            for (int m = 0; m < 4; ++m) rsv[ai][m] = rstd_of(ssq, u.pm * BM + ai * HALF + wr * 64 + 16 * m + fr);
        f32x4 w0[2], w1[2], w2[2];
#pragma unroll
        for (int n = 0; n < 2; ++n) { w0[n] = *(const f32x4*)(cw + ch0 + 4 * n) * L2E; w1[n] = *(const f32x4*)(cw + FF + ch0 + 4 * n) * L2E; w2[n] = *(const f32x4*)(cw + 2 * FF + ch0 + 4 * n) * L2E; }
#pragma unroll
        for (int ai = 0; ai < 2; ++ai) {
            const int rowb = u.pm * BM + ai * HALF + wr * 64, grp = rowb >> 6;
            f32x4 p1prev[2], p2prev[2];
#pragma unroll
            for (int n = 0; n < 2; ++n) { p1prev[n] = (f32x4){0.f, 0.f, 0.f, 0.f}; p2prev[n] = (f32x4){0.f, 0.f, 0.f, 0.f}; }
#pragma unroll
            for (int m = 0; m < 4; ++m) {
                const float rs = rsv[ai][m]; u32x4 wv;
#pragma unroll
                for (int n = 0; n < 2; ++n) {
                    const f32x4 A = acc[ai][0][m][n] * rs, Gs = acc[ai][1][m][n] * rs;
                    if (m == 0 && fr < 2) { *(f32x4*)(edgeA + ((size_t)grp * 4 + fr) * FF + ch0 + 4 * n) = A; *(f32x4*)(edgeG + ((size_t)grp * 2 + fr) * FF + ch0 + 4 * n) = Gs; }
                    if (m == 3 && fr >= 14) { *(f32x4*)(edgeA + ((size_t)grp * 4 + 2 + (fr - 14)) * FF + ch0 + 4 * n) = A; }
                    f32x4 r1, r2, q1, q2;
#pragma unroll
                    for (int e = 0; e < 4; ++e) { r1[e] = ror1f(A[e]); r2[e] = ror2f(A[e]); q1[e] = ge1 ? r1[e] : p1prev[n][e]; q2[e] = ge2 ? r2[e] : p2prev[n][e]; }
                    const f32x4 c = w0[n] * q2 + w1[n] * q1 + w2[n] * A;
                    f32x4 d;
#pragma unroll
                    for (int e = 0; e < 4; ++e) d[e] = __builtin_amdgcn_exp2f(-c[e]);
                    d = d + 1.0f;
#pragma unroll
                    for (int e = 0; e < 4; ++e) d[e] = __builtin_amdgcn_rcpf(d[e]);
                    const f32x4 h = (c * d) * (Gs * LN2);
                    p1prev[n] = r1; p2prev[n] = r2;
                    if (n == 0) { wv.x = cvt_pk_bf16(h[0], h[1]); wv.y = cvt_pk_bf16(h[2], h[3]); } else { wv.z = cvt_pk_bf16(h[0], h[1]); wv.w = cvt_pk_bf16(h[2], h[3]); }
                }
                if (m > 0 || fr >= 2) *(u32x4*)(Hh + (size_t)(rowb + 16 * m + fr) * FF + ch0) = wv;
            }
        }
    }
};

template <class Epi, class Sched, bool ALIGN_EPI = false, bool SP2 = false>
__device__ __forceinline__ void gemm_phase(PG8_LAS unsigned char* lds, const Gemm g, const Sched& S, const Epi& E, const int tid) {
    const int wid = __builtin_amdgcn_readfirstlane(tid >> 6), lane = tid & 63, wr = wid >> 2, wc = wid & 3, fr = lane & 15, fq = lane >> 4;
    const int K = g.K, nt = K / BK;
    unsigned voffA[2], voffB[2];
#pragma unroll
    for (int i = 0; i < 2; ++i) { int R, C; stage_rc(tid * 16 + i * 8192, R, C); const int Rb = Epi::PERM ? ((R & ~31) + perm32(R & 31)) : R;
        voffA[i] = (unsigned)(R * K + C) * 2u; voffB[i] = (unsigned)(Rb * K + C) * 2u; }
    const size_t kstep = (size_t)(BK * 2);
    const size_t hstep = (size_t)HALF * K * 2;
    const size_t tstep = 2 * hstep;
    const unsigned ldsw = (unsigned)wid * 1024u;
    const int aoff = lds_byte(wr * 64 + fr, fq * 8), boff = lds_byte(wc * 32 + fr, fq * 8);
#define PG8_SA(b, h) (((b) * 2 + (h)) * HTB)
#define PG8_SB(b, h) ((4 + (b) * 2 + (h)) * HTB)
#define PG8_STAGE(bufoff, gbase, voff) do { _Pragma("unroll") for (int _i = 0; _i < 2; ++_i) \
        __builtin_amdgcn_global_load_lds((const unsigned*)((const char*)(gbase) + (voff)[_i]), (PG8_LAS unsigned*)(lds + (bufoff) + ldsw + _i * 8192), 16, 0, 0); } while (0)
#define PG8_LDA(dst, b, h) do { _Pragma("unroll") for (int m = 0; m < 4; ++m) _Pragma("unroll") for (int k = 0; k < 2; ++k) dst[m][k] = *(const PG8_LAS bf16x8*)(lds + PG8_SA(b, h) + aoff + m * 2048 + k * 1024); } while (0)
#define PG8_LDB(dst, b, h) do { _Pragma("unroll") for (int n = 0; n < 2; ++n) _Pragma("unroll") for (int k = 0; k < 2; ++k) dst[n][k] = *(const PG8_LAS bf16x8*)(lds + PG8_SB(b, h) + boff + n * 2048 + k * 1024); } while (0)
#define PG8_MMA(ai, bj, At, Bt) do { __builtin_amdgcn_s_setprio(1); _Pragma("unroll") for (int m = 0; m < 4; ++m) _Pragma("unroll") for (int n = 0; n < 2; ++n) _Pragma("unroll") for (int k = 0; k < 2; ++k) \
        acc[ai][bj][m][n] = __builtin_amdgcn_mfma_f32_16x16x32_bf16(Bt[n][k], At[m][k], acc[ai][bj][m][n], 0, 0, 0); __builtin_amdgcn_s_setprio(0); } while (0)
#define PG8_WAIT_V(n) asm volatile("s_waitcnt vmcnt(" #n ")" ::: "memory")
#define PG8_WAIT_L(n) asm volatile("s_waitcnt lgkmcnt(" #n ")" ::: "memory")
#define PG8_BAR __builtin_amdgcn_s_barrier()
#define PG8_SCHED __builtin_amdgcn_sched_barrier(0)
    Unit cur, nxt; int ui = 0;
    if (!S.next(0, cur)) return;
    f32x4 acc[2][2][4][2];
#pragma unroll
    for (int a = 0; a < 2; ++a)
#pragma unroll
        for (int b = 0; b < 2; ++b)
#pragma unroll
            for (int m = 0; m < 4; ++m)
#pragma unroll
                for (int n = 0; n < 2; ++n) acc[a][b][m][n] = (f32x4){0.f, 0.f, 0.f, 0.f};
    bf16x8 At[4][2], B0[2][2], B1[2][2];
    const char* cA = (const char*)g.A + (size_t)cur.pm * tstep; const char* cB = (const char*)g.Bt + (size_t)cur.pn * tstep;
    S.a_ready(cur);
    if constexpr (SP2) {
        PG8_STAGE(PG8_SB(0, 0), cB, voffB); PG8_STAGE(PG8_SB(0, 1), cB + hstep, voffB); PG8_STAGE(PG8_SA(0, 0), cA, voffA); PG8_STAGE(PG8_SA(0, 1), cA + hstep, voffA);
        if (wr == 1) PG8_BAR;
        PG8_WAIT_V(2); PG8_BAR;
        PG8_STAGE(PG8_SB(1, 0), cB + kstep, voffB); PG8_STAGE(PG8_SA(1, 0), cA + kstep, voffA); PG8_STAGE(PG8_SB(1, 1), cB + hstep + kstep, voffB);
        PG8_WAIT_V(6); PG8_BAR;
    } else {
        PG8_STAGE(PG8_SB(0, 0), cB, voffB); PG8_STAGE(PG8_SA(0, 0), cA, voffA); PG8_STAGE(PG8_SB(0, 1), cB + hstep, voffB); PG8_STAGE(PG8_SA(0, 1), cA + hstep, voffA);
        if (wr == 1) PG8_BAR;
        PG8_WAIT_V(4); PG8_BAR;
        PG8_STAGE(PG8_SB(1, 0), cB + kstep, voffB); PG8_STAGE(PG8_SA(1, 0), cA + kstep, voffA); PG8_STAGE(PG8_SB(1, 1), cB + hstep + kstep, voffB);
        PG8_WAIT_V(6); PG8_BAR;
    }
    for (;;) {
        const bool has_next = S.next(ui + 1, nxt);
        const char* nA = has_next ? (const char*)g.A + (size_t)nxt.pm * tstep : cA; const char* nB = has_next ? (const char*)g.Bt + (size_t)nxt.pn * tstep : cB;
        for (int t = 0; t < nt; t += 2) {
            const bool last = (t == nt - 2);
            const char* a1 = cA + (size_t)(t + 1) * kstep;
            const char* a2 = last ? nA : cA + (size_t)(t + 2) * kstep; const char* b2 = last ? nB : cB + (size_t)(t + 2) * kstep;
            const char* a3 = a2 + kstep; const char* b3 = b2 + kstep;
            if (last && has_next) S.a_ready(nxt);
            if constexpr (SP2) {
            PG8_LDB(B0, 0, 0); PG8_LDB(B1, 0, 1); PG8_SCHED; PG8_LDA(At, 0, 0); PG8_STAGE(PG8_SA(1, 1), a1 + hstep, voffA);
            PG8_WAIT_V(8); PG8_WAIT_L(0); PG8_BAR; PG8_MMA(0, 0, At, B0); PG8_MMA(0, 1, At, B1); PG8_BAR; PG8_SCHED;
            PG8_LDA(At, 0, 1); PG8_STAGE(PG8_SB(0, 0), b2, voffB); PG8_STAGE(PG8_SB(0, 1), b2 + hstep, voffB); PG8_STAGE(PG8_SA(0, 0), a2, voffA);
            PG8_WAIT_V(8); PG8_WAIT_L(0); PG8_BAR; PG8_MMA(1, 0, At, B0); PG8_MMA(1, 1, At, B1); PG8_BAR; PG8_SCHED;
            PG8_LDB(B0, 1, 0); PG8_LDB(B1, 1, 1); PG8_SCHED; PG8_LDA(At, 1, 0); PG8_STAGE(PG8_SA(0, 1), a2 + hstep, voffA);
            PG8_WAIT_V(8); PG8_WAIT_L(0); PG8_BAR; PG8_MMA(0, 0, At, B0); PG8_MMA(0, 1, At, B1); PG8_BAR; PG8_SCHED;
            PG8_LDA(At, 1, 1); PG8_STAGE(PG8_SB(1, 0), b3, voffB); PG8_STAGE(PG8_SB(1, 1), b3 + hstep, voffB); PG8_STAGE(PG8_SA(1, 0), a3, voffA);
            PG8_WAIT_V(8); PG8_WAIT_L(0); PG8_BAR; PG8_MMA(1, 0, At, B0); PG8_MMA(1, 1, At, B1); PG8_BAR; PG8_SCHED;
            } else {
            PG8_LDB(B0, 0, 0); PG8_SCHED; PG8_LDA(At, 0, 0); PG8_STAGE(PG8_SA(1, 1), a1 + hstep, voffA);
            PG8_WAIT_L(8); PG8_BAR; PG8_WAIT_L(0); PG8_MMA(0, 0, At, B0); PG8_BAR; PG8_SCHED;
            PG8_LDB(B1, 0, 1); PG8_STAGE(PG8_SB(0, 0), b2, voffB);
            PG8_BAR; PG8_WAIT_L(0); PG8_MMA(0, 1, At, B1); PG8_BAR;
            PG8_LDA(At, 0, 1); PG8_STAGE(PG8_SA(0, 0), a2, voffA);
            PG8_BAR; PG8_WAIT_L(0); PG8_MMA(1, 0, At, B0); PG8_BAR; PG8_SCHED;
            PG8_STAGE(PG8_SB(0, 1), b2 + hstep, voffB);
            PG8_WAIT_V(6); PG8_BAR; PG8_MMA(1, 1, At, B1); PG8_BAR;
            PG8_LDB(B0, 1, 0); PG8_SCHED; PG8_LDA(At, 1, 0); PG8_STAGE(PG8_SA(0, 1), a2 + hstep, voffA);
            PG8_WAIT_L(8); PG8_BAR; PG8_WAIT_L(0); PG8_MMA(0, 0, At, B0); PG8_BAR; PG8_SCHED;
            PG8_LDB(B1, 1, 1); PG8_STAGE(PG8_SB(1, 0), b3, voffB);
            PG8_BAR; PG8_WAIT_L(0); PG8_MMA(0, 1, At, B1); PG8_BAR;
            PG8_LDA(At, 1, 1); PG8_STAGE(PG8_SA(1, 0), a3, voffA);
            PG8_BAR; PG8_WAIT_L(0); PG8_MMA(1, 0, At, B0); PG8_BAR; PG8_SCHED;
            PG8_STAGE(PG8_SB(1, 1), b3 + hstep, voffB);
            PG8_WAIT_V(6); PG8_BAR; PG8_MMA(1, 1, At, B1); PG8_BAR;
            }
        }
        if constexpr (ALIGN_EPI) { if (wr == 0) PG8_BAR; }
        if constexpr (!Epi::AFTER_DRAIN) { E(acc, cur, wr, wc, fr, fq); S.done(cur); }
        if (!has_next) break;
#pragma unroll
        for (int a = 0; a < 2; ++a)
#pragma unroll
            for (int b = 0; b < 2; ++b)
#pragma unroll
                for (int m = 0; m < 4; ++m)
#pragma unroll
                    for (int n = 0; n < 2; ++n) acc[a][b][m][n] = (f32x4){0.f, 0.f, 0.f, 0.f};
        cur = nxt; cA = nA; cB = nB; ++ui;
        if constexpr (ALIGN_EPI) { if (wr == 1) PG8_BAR; }
    }
    PG8_WAIT_V(0);
    if constexpr (!ALIGN_EPI) { if (wr == 0) PG8_BAR; }
    PG8_BAR;
    if constexpr (Epi::AFTER_DRAIN) { E.fused(acc, cur, wr, wc, fr, fq, lds, wid, lane); S.done(cur); }
#undef PG8_SA
#undef PG8_SB
#undef PG8_STAGE
#undef PG8_LDA
#undef PG8_LDB
#undef PG8_MMA
#undef PG8_WAIT_V
#undef PG8_WAIT_L
#undef PG8_BAR
#undef PG8_SCHED
}
}

#ifndef PG8_SP2
#define PG8_SP2 true
#endif
#ifndef PG8_ALIGN
#define PG8_ALIGN true
#endif
#include <hip/hip_bf16.h>
#include <cmath>
namespace attn_body {
using bf16=__hip_bfloat16;
using bf16x8=__attribute__((ext_vector_type(8)))short;
using s16x4=__attribute__((ext_vector_type(4)))short;
using f32x16=__attribute__((ext_vector_type(16)))float;
using u32x4=__attribute__((ext_vector_type(4)))unsigned;
using f32x4v=__attribute__((ext_vector_type(4)))float;
constexpr int BATCH=4,NHEAD=16,SEQ=8192,D=64,DM=NHEAD*D;
constexpr int NW=8,QBLK=32,QB=QBLK*NW,KVBLK=64,NQB=SEQ/QB;
constexpr int ATTN_PITCH=DM, ATTN_UNIT_ROWS=QB;
__device__ __forceinline__ int crow(int r,int hi){return (r&3)+8*(r>>2)+4*hi;}
#define SBAR() __builtin_amdgcn_sched_barrier(0)
__device__ __forceinline__ void cmask(f32x16&p0,f32x16&p1,int jb,int qrel,int hi){
  const float NEG=-INFINITY; int q2=qrel-64*jb-4*hi; asm volatile("":"+v"(q2));
  #pragma unroll
  for(int r=0;r<16;++r){const int c=(r&3)+8*(r>>2); if(c>q2)p0[r]=NEG; if(c+32>q2)p1[r]=NEG;}
}

constexpr int NSLOT=3, SLOTB=8192;
constexpr int LDS_K=0, LDS_V=NSLOT*SLOTB, LDS_WS=2*NSLOT*SLOTB, LDS_OST=LDS_WS+NW*64*4, LDS_BYTES=LDS_OST+NW*4096, LDS_KX=86016, LDS_TOTAL=LDS_KX+SEQ*8;
constexpr float C2=0.125f*1.4426950408889634f;
__device__ __forceinline__ void glds16(const void*gsrc,unsigned lds_dst){unsigned keep;
  asm volatile("s_mov_b32 %0, m0\n\ts_mov_b32 m0, %2\n\ts_nop 0\n\tglobal_load_lds_dwordx4 %1, off\n\ts_mov_b32 m0, %0":"=&s"(keep):"v"(gsrc),"s"(lds_dst):"memory");}
__device__ __forceinline__ float max3f(float a,float b,float c){float r;asm("v_max3_f32 %0, %1, %2, %3":"=v"(r):"v"(a),"v"(b),"v"(c));return r;}
__device__ __forceinline__ float max2f(float a,float b){float r;asm("v_max_f32_e32 %0, %1, %2":"=v"(r):"v"(a),"v"(b));return r;}
__device__ __forceinline__ float fadd_s(float a,float b){float r;asm("v_add_f32_e32 %0, %1, %2":"=v"(r):"v"(a),"v"(b));return r;}
__device__ __forceinline__ float fsub_s(float a,float b){float r;asm("v_sub_f32_e32 %0, %1, %2":"=v"(r):"v"(a),"v"(b));return r;}
typedef float f32x2_t __attribute__((ext_vector_type(2))); typedef __bf16 bf16x2_t __attribute__((ext_vector_type(2)));
__device__ __forceinline__ unsigned cvtpk_s(float lo,float hi){f32x2_t v={lo,hi};bf16x2_t b=__builtin_convertvector(v,bf16x2_t);return __builtin_bit_cast(unsigned,b);}
#define WAIT_BAR(N) asm volatile("s_waitcnt vmcnt(" #N ") lgkmcnt(0)\n\ts_barrier":::"memory")

__device__ __forceinline__ void qkt(f32x16&p0,f32x16&p1,const char*Kslot,const bf16x8*qr,const f32x16&negm,int r32,int hi){
  const char*kb=Kslot+hi*1024+r32*16;
  #pragma unroll
  for(int d0=0;d0<4;++d0){
    const bf16x8 b0=*reinterpret_cast<const bf16x8*>(kb+d0*2048);
    const bf16x8 b1=*reinterpret_cast<const bf16x8*>(kb+d0*2048+512);
    if(d0==0){p0=__builtin_amdgcn_mfma_f32_32x32x16_bf16(b0,qr[0],f32x16{},0,0,0);p1=__builtin_amdgcn_mfma_f32_32x32x16_bf16(b1,qr[0],f32x16{},0,0,0);}
    else{p0=__builtin_amdgcn_mfma_f32_32x32x16_bf16(b0,qr[d0],p0,0,0,0);p1=__builtin_amdgcn_mfma_f32_32x32x16_bf16(b1,qr[d0],p1,0,0,0);}}
}
typedef __attribute__((address_space(3))) const char* lds_cptr;
typedef short v4i16_t __attribute__((ext_vector_type(4)));
__device__ __forceinline__ void kload8(bf16x8*kf,lds_cptr kp){
  kf[0]=*(const __attribute__((address_space(3))) bf16x8*)(kp);      kf[1]=*(const __attribute__((address_space(3))) bf16x8*)(kp+512);
  kf[2]=*(const __attribute__((address_space(3))) bf16x8*)(kp+2048); kf[3]=*(const __attribute__((address_space(3))) bf16x8*)(kp+2560);
  kf[4]=*(const __attribute__((address_space(3))) bf16x8*)(kp+4096); kf[5]=*(const __attribute__((address_space(3))) bf16x8*)(kp+4608);
  kf[6]=*(const __attribute__((address_space(3))) bf16x8*)(kp+6144); kf[7]=*(const __attribute__((address_space(3))) bf16x8*)(kp+6656);
}
__device__ __forceinline__ void kload2(bf16x8*kf,lds_cptr kp,int j){ kf[2*j]=*(const __attribute__((address_space(3))) bf16x8*)(kp+j*2048); kf[2*j+1]=*(const __attribute__((address_space(3))) bf16x8*)(kp+j*2048+512); }
__device__ __forceinline__ s16x4 vtr(lds_cptr p){ return __builtin_bit_cast(s16x4,__builtin_amdgcn_ds_read_tr16_b64_v4i16((__attribute__((address_space(3))) v4i16_t*)p)); }
__device__ __forceinline__ float rowmax(const f32x16&p0,const f32x16&p1){
  float a=max3f(p0[0],p0[1],p1[0]),b=max3f(p0[2],p0[3],p1[1]);a=max3f(a,p1[2],p1[3]);
  #pragma unroll
  for(int r=4;r<16;r+=4){a=max3f(a,p0[r],p0[r+1]);b=max3f(b,p0[r+2],p0[r+3]);a=max3f(a,p1[r],p1[r+1]);b=max3f(b,p1[r+2],p1[r+3]);}
  const float m=max2f(a,b);
  auto rr=__builtin_amdgcn_permlane32_swap(__float_as_uint(m),__float_as_uint(m),false,false);
  return max2f(__uint_as_float(rr[0]),__uint_as_float(rr[1]));
}
__device__ __forceinline__ void pv(f32x16*o,int vb,bf16x8 pa0,bf16x8 pa1,bf16x8 pa2,bf16x8 pa3){
  #pragma unroll
  for(int d0=0;d0<2;++d0){s16x4 lo[4],hi[4];
    #pragma unroll
    for(int ks=0;ks<4;++ks){
      asm volatile("ds_read_b64_tr_b16 %0,%1 offset:%c2":"=&v"(lo[ks]):"v"(vb),"i"(d0*4096+ks*1024):"memory");
      asm volatile("ds_read_b64_tr_b16 %0,%1 offset:%c2":"=&v"(hi[ks]):"v"(vb),"i"(d0*4096+ks*1024+512):"memory");}
    asm volatile("s_waitcnt lgkmcnt(0)":::"memory");SBAR();
    #define PK(k) (bf16x8){lo[k][0],lo[k][1],lo[k][2],lo[k][3],hi[k][0],hi[k][1],hi[k][2],hi[k][3]}
    o[d0]=__builtin_amdgcn_mfma_f32_32x32x16_bf16(pa0,PK(0),o[d0],0,0,0);
    o[d0]=__builtin_amdgcn_mfma_f32_32x32x16_bf16(pa1,PK(1),o[d0],0,0,0);
    o[d0]=__builtin_amdgcn_mfma_f32_32x32x16_bf16(pa2,PK(2),o[d0],0,0,0);
    o[d0]=__builtin_amdgcn_mfma_f32_32x32x16_bf16(pa3,PK(3),o[d0],0,0,0);
    #undef PK
  }
}

#ifndef ATTN_STORE16
#define ATTN_STORE16(p,v) (*(u32x4*)(p)=(v))
#endif
template<int THRL> __device__ __forceinline__ void attn_unit(int b,int h,int qb,const bf16*Q,const bf16*__restrict__ K,const bf16*__restrict__ V,bf16*O,const bf16*SG,const unsigned*KXG,const int j0,const float BND,char*shm,const int tid,const bool kv0=false){
  const int lane=tid&63,r32=lane&31,hi=lane>>5; const int wid=__builtin_amdgcn_readfirstlane(tid>>6);
  const long rowbase=(long)b*SEQ; const int q0=qb*QB;
  const bf16*Qw=Q+(rowbase+q0+wid*QBLK)*DM+h*D;
  const int NT0=(q0+QB)/KVBLK;
  const bf16*Kh=K+((kv0?0l:rowbase)+(long)j0*KVBLK)*DM+(kv0?0:h)*D,*Vh=V+((kv0?0l:rowbase)+(long)j0*KVBLK)*DM+(kv0?0:h)*D;
  const unsigned lds0=(unsigned)(uintptr_t)shm;
  float*wsf=(float*)(shm+LDS_WS)+wid*64;
  const bf16*ksrc=Kh+(long)lane*DM+wid*8;
  const bf16*vsrc=Vh+(long)(16*(wid&3)+(lane>>2))*DM+(wid>>2)*32+(lane&3)*8;
  const unsigned kdst=lds0+LDS_K+wid*1024, vdst=lds0+LDS_V+wid*1024;
  #define DMA_K(t,slot) glds16(ksrc+(long)(t)*KVBLK*DM,(unsigned)__builtin_amdgcn_readfirstlane(kdst+(slot)))
  #define DMA_V(t,slot) glds16(vsrc+(long)(t)*KVBLK*DM,(unsigned)__builtin_amdgcn_readfirstlane(vdst+(slot)))
  const int vb0=(int)(lds0+LDS_V)+((lane>>4)&1)*32+(lane&3)*8+(4*hi+((lane&15)>>2))*64;
  const char*Kbase=shm+LDS_K; bf16x8 kf[8];
  const lds_cptr shm3=(lds_cptr)shm; const lds_cptr kp0=shm3+LDS_K+hi*1024+r32*16; const lds_cptr vp0=shm3+LDS_V+((lane>>4)&1)*32+(lane&3)*8+(4*hi+((lane&15)>>2))*64;
  const int NT=NT0-j0;
  DMA_K(0,0);DMA_V(0,0);DMA_K(1,SLOTB);
  bf16x8 qr[4];
  #pragma unroll
  for(int d0=0;d0<4;++d0)qr[d0]=*reinterpret_cast<const bf16x8*>(&Qw[(long)r32*DM+d0*16+hi*8]);
  float mhat=0.f,l_reg=0.f;f32x16 o[2];o[0]=f32x16{};o[1]=f32x16{};f32x16 negm=f32x16{};
  const int qrel=wid*QBLK+r32;
  #define CMASK(P0,P1,t) do{int jb_=(t)-(NT-4); if(jb_>=0)cmask(P0,P1,jb_,qrel,hi);}while(0)
  #define START(P0,P1) do{ _Pragma("unroll") for(int r=0;r<16;++r)P0[r]=__builtin_amdgcn_exp2f(P0[r]); }while(0)
  #define RESC() do{}while(0)
  f32x16 pA0,pA1,pB0,pB1;
  int sl_prev=0,sl_cur=0,sl_next=SLOTB;
  #define ROT() do{sl_prev=sl_cur;sl_cur=sl_next;sl_next=(sl_next==(NSLOT-1)*SLOTB)?0:sl_next+SLOTB;}while(0)
  typedef __attribute__((address_space(3))) char lds_char; typedef __attribute__((ext_vector_type(2))) unsigned u32x2v;
  typedef __attribute__((address_space(3))) u32x4 lds_u32x4; typedef __attribute__((address_space(3))) u32x2v lds_u32x2;
  lds_char* const kx3=(lds_char*)shm+LDS_KX+j0*512;
  { lds_char* const kxw=(lds_char*)shm+LDS_KX; const u32x4* kxs=(const u32x4*)(KXG+(long)(b*NHEAD+h)*SEQ*2);
    int tid_n=tid; asm volatile("":"+v"(tid_n));
    for(int p_=j0*(KVBLK/2)+tid_n;p_<(q0+QB)/2;p_+=NW*64){ *(lds_u32x4*)(kxw+p_*16)=kxs[p_]; } }
  u32x4 qxv=(hi==0)?(u32x4){0x3f803f80u,0x00003f80u,0u,0u}:(u32x4){0u,0u,0u,0u};
  #define qx __builtin_bit_cast(bf16x8,qxv)
  #define SETQX() do{ const float nm_=-mhat; const unsigned h_=cvtpk_s(nm_,0.f)&0xffffu; const float r1_=nm_-__uint_as_float(h_<<16); const unsigned m_=cvtpk_s(r1_,0.f)&0xffffu; \
    const float r2_=r1_-__uint_as_float(m_<<16); const unsigned l_=cvtpk_s(r2_,0.f)&0xffffu; qxv.y=(hi==0)?(0x3f80u|(h_<<16)):0u; qxv.z=(hi==0)?(m_|(l_<<16)):0u; }while(0)
  u32x2v kxa,kxb;
  #define KXLD(t) do{ const lds_u32x2* p_=(const lds_u32x2*)(kx3+(t)*512+r32*8); kxa=p_[0]; kxb=p_[32]; }while(0)
  #define KXF(v) __builtin_bit_cast(bf16x8,(u32x4){(v).x,(v).y,0x3f803f80u,0u})
  { const unsigned* kq_=KXG+((long)(b*NHEAD+h)*SEQ+q0+wid*QBLK+r32)*2; const unsigned w0_=kq_[0], w1_=kq_[1];
    mhat=(__uint_as_float(w0_<<16)+__uint_as_float(w0_&0xffff0000u))+__uint_as_float(w1_<<16)+BND; SETQX(); }
  DMA_K(2,2*SLOTB);
  WAIT_BAR(3);
  KXLD(0); qkt(pA0,pA1,Kbase,qr,negm,r32,hi); pA0=__builtin_amdgcn_mfma_f32_32x32x16_bf16(KXF(kxa),qx,pA0,0,0,0); pA1=__builtin_amdgcn_mfma_f32_32x32x16_bf16(KXF(kxb),qx,pA1,0,0,0);
  asm volatile("s_nop 15\n\ts_nop 7":"+v"(pA0),"+v"(pA1));CMASK(pA0,pA1,0);
  START(pA0,pA1);
  _Pragma("unroll") for(int r=0;r<16;++r)pA1[r]=__builtin_amdgcn_exp2f(pA1[r]);
  WAIT_BAR(0);
  DMA_K(3,0);DMA_V(1,SLOTB);
  ROT();
  kload8(kf,kp0+sl_cur); KXLD(1);
  WAIT_BAR(2);
  s16x4 vlo[8],vhi[8]; u32x4 pw0,pw1,pw2,pw3;
  #define PKW(P,B) cvtpk_s(P[B],P[B+1])
  #define PAF(k) __builtin_bit_cast(bf16x8,pw##k)
  #define VFR(i) (bf16x8){vlo[i][0],vlo[i][1],vlo[i][2],vlo[i][3],vhi[i][0],vhi[i][1],vhi[i][2],vhi[i][3]}
  #define PIN(x) asm volatile("":"+v"(x))
  #define MX3(a,b,c) __builtin_fmaxf(__builtin_fmaxf((a),(b)),(c))
  #define GAPA(MF,A0,A1,A2,A3,W0,W1,PW) do{ MF; sacc+=A0; sacc+=A1; sacc+=A2; sacc+=A3; PIN(sacc); W0; W1; PIN(PW); SBAR(); }while(0)
  #define EX(v) __builtin_amdgcn_exp2f(v)
  #define GAPB(MF,X,B) do{ MF; X[B]=EX(X[B]); X[B+1]=EX(X[B+1]); X[B+2]=EX(X[B+2]); X[B+3]=EX(X[B+3]); PIN(X); SBAR(); }while(0)
  #define VRD(i) do{ vlo[i]=vtr(vp_+(((i)>>2)*4096+((i)&3)*1024)); vhi[i]=vtr(vp_+(((i)>>2)*4096+((i)&3)*1024+512)); }while(0)
  #define KRD(G,j) do{ if(G){ kload2(kf,kp0+sl_next,j); SBAR(); } }while(0)
  #define KXRD(G,t) do{ if(G){ KXLD((t)+1); SBAR(); } }while(0)
  #define STEP(C0,C1,P0,P1,t,GK,GV,GL) do{ SBAR(); \
    const lds_cptr vp_=vp0+sl_prev; \
    VRD(0); SBAR(); float sacc=(P0[0]+P0[1]); \
    GAPA(C0=__builtin_amdgcn_mfma_f32_32x32x16_bf16(kf[0],qr[0],f32x16{},0,0,0), P0[2],P0[3],P0[4],P0[5],     pw0[0]=PKW(P0,0), pw0[1]=PKW(P0,2), pw0); \
    VRD(4); SBAR(); GAPA(C1=__builtin_amdgcn_mfma_f32_32x32x16_bf16(kf[1],qr[0],f32x16{},0,0,0), P0[6],P0[7],P0[8],P0[9],     pw0[2]=PKW(P0,4), pw0[3]=PKW(P0,6), pw0); \
    VRD(1); SBAR(); GAPA(C0=__builtin_amdgcn_mfma_f32_32x32x16_bf16(kf[2],qr[1],C0,0,0,0),   P0[10],P0[11],P0[12],P0[13], pw1[0]=PKW(P0,8), pw1[1]=PKW(P0,10), pw1); \
    VRD(5); SBAR(); GAPA(C1=__builtin_amdgcn_mfma_f32_32x32x16_bf16(kf[3],qr[1],C1,0,0,0),   P0[14],P0[15],P1[0],P1[1],   pw1[2]=PKW(P0,12),pw1[3]=PKW(P0,14), pw1); \
    VRD(2); SBAR(); GAPA(C0=__builtin_amdgcn_mfma_f32_32x32x16_bf16(kf[4],qr[2],C0,0,0,0),   P1[2],P1[3],P1[4],P1[5],     pw2[0]=PKW(P1,0), pw2[1]=PKW(P1,2), pw2); \
    VRD(6); SBAR(); GAPA(C1=__builtin_amdgcn_mfma_f32_32x32x16_bf16(kf[5],qr[2],C1,0,0,0),   P1[6],P1[7],P1[8],P1[9],     pw2[2]=PKW(P1,4), pw2[3]=PKW(P1,6), pw2); \
    VRD(3); SBAR(); GAPA(C0=__builtin_amdgcn_mfma_f32_32x32x16_bf16(kf[6],qr[3],C0,0,0,0),   P1[10],P1[11],P1[12],P1[13], pw3[0]=PKW(P1,8), pw3[1]=PKW(P1,10), pw3); \
    VRD(7); SBAR(); GAPA(C1=__builtin_amdgcn_mfma_f32_32x32x16_bf16(kf[7],qr[3],C1,0,0,0),   P1[14],P1[15],0.f,0.f,       pw3[2]=PKW(P1,12),pw3[3]=PKW(P1,14), pw3); \
    C0=__builtin_amdgcn_mfma_f32_32x32x16_bf16(KXF(kxa),qx,C0,0,0,0); C1=__builtin_amdgcn_mfma_f32_32x32x16_bf16(KXF(kxb),qx,C1,0,0,0); SBAR(); \
    l_reg+=sacc; \
    if(GK){DMA_K((t)+3,sl_cur);} if(GV){DMA_V((t)+1,sl_next);} \
    CMASK(C0,C1,t); \
    SBAR(); \
    GAPB(o[0]=__builtin_amdgcn_mfma_f32_32x32x16_bf16(PAF(0),VFR(0),o[0],0,0,0), C0,0); \
    GAPB(o[1]=__builtin_amdgcn_mfma_f32_32x32x16_bf16(PAF(0),VFR(4),o[1],0,0,0), C0,4); \
    KRD(GL,0); GAPB(o[0]=__builtin_amdgcn_mfma_f32_32x32x16_bf16(PAF(1),VFR(1),o[0],0,0,0), C0,8); \
    KRD(GL,1); GAPB(o[1]=__builtin_amdgcn_mfma_f32_32x32x16_bf16(PAF(1),VFR(5),o[1],0,0,0), C0,12); \
    KRD(GL,2); GAPB(o[0]=__builtin_amdgcn_mfma_f32_32x32x16_bf16(PAF(2),VFR(2),o[0],0,0,0), C1,0); \
    KRD(GL,3); GAPB(o[1]=__builtin_amdgcn_mfma_f32_32x32x16_bf16(PAF(2),VFR(6),o[1],0,0,0), C1,4); KXRD(GL,t); \
    GAPB(o[0]=__builtin_amdgcn_mfma_f32_32x32x16_bf16(PAF(3),VFR(3),o[0],0,0,0), C1,8); \
    GAPB(o[1]=__builtin_amdgcn_mfma_f32_32x32x16_bf16(PAF(3),VFR(7),o[1],0,0,0), C1,12); \
    }while(0)
  int t=1;
  #undef CMASK
  #define CMASK(P0,P1,t) do{}while(0)
  for(;t+5<NT;t+=2){
    STEP(pB0,pB1,pA0,pA1,t,true,true,true);     WAIT_BAR(2); RESC(); ROT();
    STEP(pA0,pA1,pB0,pB1,t+1,true,true,true);   WAIT_BAR(2); RESC(); ROT();
  }
  #undef CMASK
  #define CMASK(P0,P1,t) do{int jb_=(t)-(NT-4); if(jb_>=0)cmask(P0,P1,jb_,qrel,hi);}while(0)
  #define ENDW(tt) do{ if((tt)+3<NT){WAIT_BAR(2);} else if((tt)+2<NT){WAIT_BAR(1);} else {WAIT_BAR(0);} }while(0)
  for(;t+1<NT;t+=2){
    STEP(pB0,pB1,pA0,pA1,t,(t+3<NT),(t+1<NT),(t+1<NT));       ENDW(t);   RESC(); ROT();
    STEP(pA0,pA1,pB0,pB1,t+1,(t+4<NT),(t+2<NT),(t+2<NT));     ENDW(t+1); RESC(); ROT();
  }
  STEP(pB0,pB1,pA0,pA1,NT-1,false,false,false); RESC();
  { float sacc=pB0[0]+pB0[1]; _Pragma("unroll") for(int r=2;r<16;++r)sacc+=pB0[r]; _Pragma("unroll") for(int r=0;r<16;++r)sacc+=pB1[r]; l_reg+=sacc;
    pw0=(u32x4){PKW(pB0,0),PKW(pB0,2),PKW(pB0,4),PKW(pB0,6)};pw1=(u32x4){PKW(pB0,8),PKW(pB0,10),PKW(pB0,12),PKW(pB0,14)};pw2=(u32x4){PKW(pB1,0),PKW(pB1,2),PKW(pB1,4),PKW(pB1,6)};pw3=(u32x4){PKW(pB1,8),PKW(pB1,10),PKW(pB1,12),PKW(pB1,14)};
    SBAR(); pv(o,vb0+sl_cur,PAF(0),PAF(1),PAF(2),PAF(3)); }
  #undef PKW
  #undef PAF
  #undef VFR
  #undef PIN
  #undef MX3
  #undef GAPA
  #undef GAPB
  #undef EX
  #undef VRD
  #undef KRD
  #undef STEP
  #undef ENDW
  {auto rr=__builtin_amdgcn_permlane32_swap(__float_as_uint(l_reg),__float_as_uint(l_reg),false,false);l_reg=__uint_as_float(rr[0])+__uint_as_float(rr[1]);}
  if(hi==0)wsf[32+r32]=l_reg;asm volatile("s_waitcnt lgkmcnt(0)":::"memory");
  float rli[16];
  #pragma unroll
  for(int r=0;r<16;++r)rli[r]=__builtin_amdgcn_rcpf(wsf[32+crow(r,hi)]);
  bf16*Ow=O+(rowbase+q0+wid*QBLK)*DM+h*D; const long sgd=(const char*)SG-(const char*)O;

  { bf16*stg=(bf16*)(shm+LDS_OST)+wid*2048;
    #pragma unroll
    for(int r=0;r<16;++r){const int orow=crow(r,hi);
      #pragma unroll
      for(int d0=0;d0<2;++d0)stg[orow*64+d0*32+r32]=__float2bfloat16(o[d0][r]*rli[r]);}
    asm volatile("s_waitcnt lgkmcnt(0)":::"memory");
    int lane_e=lane; asm volatile("":"+v"(lane_e));
    u32x4 gvv[4];
    #pragma unroll
    for(int i=0;i<4;++i)gvv[i]=*(const u32x4*)((const char*)(Ow+(long)(i*8+(lane_e>>3))*DM+(lane_e&7)*8)+sgd);
    #pragma unroll
    for(int i=0;i<4;++i){const int row=i*8+(lane_e>>3),ch=lane_e&7; u32x4 v=*(const u32x4*)(stg+row*64+ch*8); const u32x4 gvi=gvv[i];
      #pragma unroll
      for(int k=0;k<4;++k){ const float lo_=__builtin_bit_cast(float,v[k]<<16)*__builtin_bit_cast(float,gvi[k]<<16), hi_=__builtin_bit_cast(float,v[k]&0xffff0000u)*__builtin_bit_cast(float,gvi[k]&0xffff0000u); v[k]=cvtpk_s(lo_,hi_); }
      ATTN_STORE16(Ow+(long)row*DM+ch*8,v);} }
  asm volatile("s_waitcnt lgkmcnt(0)\n\ts_barrier":::"memory");
  #undef KXLD
  #undef qx
  #undef SETQX
  #undef KXF
  #undef KXRD
  #undef DMA_K
  #undef DMA_V
  #undef CMASK
  #undef START
  #undef RESC
  #undef ROT
}
constexpr int ATTN_LDS_BYTES=LDS_BYTES;
struct AttnTensors { const bf16* Q; const bf16* K; const bf16* V; bf16* O; const bf16* SG; const unsigned* KXG; const unsigned* J0T; };
struct AttnUnit { int bh; int qb; };
struct StaticOrder {
  int vcu;
  __device__ __forceinline__ explicit StaticOrder(int grid,int block):vcu((block%8)*(grid/8)+block/8){}
  __device__ __forceinline__ bool next(int i,AttnUnit&u)const{ if(i>=8)return false; const int s=vcu&7,j=i&3; u.bh=(vcu>>3)+32*(i>>2); u.qb=(j==0)?s:(j==1)?15-s:(j==2)?16+s:31-s; return true; }
  __device__ __forceinline__ void a_ready(const AttnUnit&)const{}
  __device__ __forceinline__ void done(const AttnUnit&)const{}
};
constexpr int LDS_QW=LDS_TOTAL, LDS_J0=LDS_TOTAL+16, LDS_ATT_END=LDS_J0+BATCH*NHEAD*NQB*4;
template<int THRL=8> __device__ __forceinline__ void attn_phase(char*lds,const AttnTensors&T,unsigned*ctr,const float BND,const int tid,const bool kv0=false){
  volatile __attribute__((address_space(3))) unsigned* qw=(volatile __attribute__((address_space(3))) unsigned*)((__attribute__((address_space(3))) char*)lds+LDS_QW);
  unsigned nxt=0u;
  volatile __attribute__((address_space(3))) unsigned* j0l=(volatile __attribute__((address_space(3))) unsigned*)((__attribute__((address_space(3))) char*)lds+LDS_J0);
  for(int i_=tid;i_<BATCH*NHEAD*NQB;i_+=NW*64)j0l[i_]=T.J0T[i_];
  if(tid==0){ qw[0]=__hip_atomic_fetch_add(ctr,1u,__ATOMIC_RELAXED,__HIP_MEMORY_SCOPE_AGENT); }
  asm volatile("s_waitcnt vmcnt(0) lgkmcnt(0)\n\ts_barrier":::"memory");
  unsigned cur=(unsigned)__builtin_amdgcn_readfirstlane((int)qw[0]);
  while(cur<(unsigned)(BATCH*NHEAD*NQB)){
    if(tid==0) nxt=__hip_atomic_fetch_add(ctr,1u,__ATOMIC_RELAXED,__HIP_MEMORY_SCOPE_AGENT);
    const int bh=(int)(cur&63u), qb=NQB-1-(int)(cur>>6);
    attn_unit<THRL>(bh/NHEAD,bh%NHEAD,qb,T.Q,T.K,T.V,T.O,T.SG,T.KXG,__builtin_amdgcn_readfirstlane((int)j0l[bh*NQB+qb]),BND,lds,tid,kv0);
    if(tid==0) qw[0]=nxt;
    asm volatile("s_waitcnt lgkmcnt(0)\n\ts_barrier":::"memory");
    cur=(unsigned)__builtin_amdgcn_readfirstlane((int)qw[0]);
  }
}
#undef SBAR
#undef WAIT_BAR
}
namespace cg = cooperative_groups;
#ifndef PROBE_X
#define PROBE_X 0
#endif
#ifndef MK_MULTI
#define MK_MULTI 0
#endif
constexpr int NWAVES = 8, NTHREADS = NWAVES * 64;
constexpr int BATCH = 4, T = 8192, D = 1024, H = 16, HD = 64, FF = 2816, M = BATCH * T;
constexpr int N_PHASES = 22;
constexpr size_t MiB = 1u << 20;
constexpr size_t WS_CTL = 1536 * 1024, CTL_BYTES = 16384;
constexpr size_t WS_WF = 2 * MiB;
constexpr size_t WS_WIN = 4 * MiB, WS_WOUT = 16 * MiB, WS_WQGKV = 20 * MiB, WS_WQG3 = 28 * MiB, WS_WBO = 32 * MiB, WS_WUP = 36 * MiB, WS_WDN = 80 * MiB;
constexpr size_t WS_XB = 104 * MiB;
constexpr size_t WS_K = 168 * MiB, WS_V = 232 * MiB;
constexpr size_t WS_ACT = 296 * MiB;
constexpr size_t WS_SG = WS_ACT + 64 * MiB;
constexpr size_t WS_EDGEA = 472 * MiB, WS_EDGEG = 494 * MiB;
constexpr size_t WS_FLT = 505 * MiB, WS_CT = 507 * MiB, WS_END = 509 * MiB;
static_assert(WS_WDN + 4 * (size_t)FF * D * 2 <= WS_XB && WS_ACT + (size_t)M * FF * 2 <= WS_EDGEA && WS_EDGEA + 512ull * 4 * FF * 4 <= WS_EDGEG && WS_EDGEG + 512ull * 2 * FF * 4 <= WS_FLT, "d_ws map");
constexpr int RING_BYTES = 131072, LDS_BYTES = 163840, LDS_BARST = LDS_BYTES - 16;
static_assert(attn_body::LDS_ATT_END <= LDS_BYTES - 16, "LDS map");

#define LAS __attribute__((address_space(3)))
typedef unsigned short bf16;
typedef unsigned v4u __attribute__((ext_vector_type(4)));
typedef unsigned v2u __attribute__((ext_vector_type(2)));
typedef float f32x4 __attribute__((ext_vector_type(4)));
typedef short bf16x8 __attribute__((ext_vector_type(8)));
#define LDS_WAIT() asm volatile("s_waitcnt lgkmcnt(0)" ::: "memory")
__device__ __forceinline__ unsigned f2bf(float f) { unsigned u = __builtin_bit_cast(unsigned, f); return (u + 0x7fffu + ((u >> 16) & 1u)) >> 16; }
__device__ __forceinline__ unsigned pk2(float lo, float hi) { return f2bf(lo) | (f2bf(hi) << 16); }
__device__ __forceinline__ float bflo(unsigned u) { return __builtin_bit_cast(float, u << 16); }
__device__ __forceinline__ float bfhi(unsigned u) { return __builtin_bit_cast(float, u & 0xffff0000u); }
__device__ __forceinline__ float wave_sum(float v) {
#pragma unroll
    for (int o = 1; o < 64; o <<= 1) v += __shfl_xor(v, o);
    return v;
}
__device__ __forceinline__ void tr_item(const float* W, int ldw, int k0, int n0, const float* gain, bf16* WT, int Kd, int drow0, int nvalid, LAS float* scr, int lane) {
    int cc = n0 + (lane & 31); if (cc >= ldw) cc = ldw - 1;
#pragma unroll 8
    for (int i = 0; i < 32; ++i) { const int kk = 2 * i + (lane >> 5); float w = W[(size_t)(k0 + kk) * ldw + cc]; if (gain) w *= gain[k0 + kk]; scr[kk * 33 + (lane & 31)] = w; }
    LDS_WAIT(); asm volatile("" ::: "memory");
    const int c = lane & 7;
#pragma unroll
    for (int j = 0; j < 4; ++j) { const int n = (lane >> 3) + 8 * j; const LAS float* s = scr + (8 * c) * 33 + n;
        v4u o; o.x = pk2(s[0 * 33], s[1 * 33]); o.y = pk2(s[2 * 33], s[3 * 33]); o.z = pk2(s[4 * 33], s[5 * 33]); o.w = pk2(s[6 * 33], s[7 * 33]);
        if (n < nvalid) *(v4u*)(WT + (size_t)(drow0 + n) * Kd + k0 + 8 * c) = o; }
    LDS_WAIT(); asm volatile("" ::: "memory");
}
__device__ __forceinline__ int headperm_row(int L0) { const int pn = L0 >> 8, w = L0 & 255; return 256 * pn + 128 * ((w & 63) >> 5) + 32 * (w >> 6); }
__device__ __forceinline__ int ffnup_row(int L0) { const int g = L0 >= FF ? 1 : 0, ch = L0 - g * FF; return 256 * (ch >> 7) + 128 * g + (ch & 127); }

#define XB_TMO      128
#define XB_XCNT(j)  (256  + 64 * (j))
#define XB_XSUB(j)  (1280 + 64 * (j))
#define XB_XGEN(j)  (2304 + 64 * (j))
#define XB_TOP      3328
#define XB_TOPGEN   3392
#define XCD_BAR_WORDS 3456
#define XB_SPIN_CAP (1u << 18)

__device__ __forceinline__ unsigned xb_ld(unsigned* p)              { return __hip_atomic_load(p, __ATOMIC_RELAXED, __HIP_MEMORY_SCOPE_AGENT); }
__device__ __forceinline__ unsigned xb_add(unsigned* p, unsigned v) { return __hip_atomic_fetch_add(p, v, __ATOMIC_RELAXED, __HIP_MEMORY_SCOPE_AGENT); }
__device__ __forceinline__ unsigned xb_xcc_id() { return (unsigned)__builtin_amdgcn_s_getreg((3 << 11) | 20) & 0xFu; }
#define XB_SPIN(cond, bar) do { unsigned _sp = 0; while (cond) { __builtin_amdgcn_s_sleep(1); \
    if ((++_sp & 255u) == 0u) { if (xb_ld(&(bar)[XB_TMO])) break; if (_sp > XB_SPIN_CAP) { atomicAdd(&(bar)[XB_TMO], 1u); break; } } } } while (0)

struct XcdBarrier {
    unsigned* bar; unsigned x;
    volatile LAS unsigned* st;
};

__device__ __forceinline__ XcdBarrier xcd_barrier_post(unsigned* bar, volatile LAS unsigned* st) {
    XcdBarrier b; b.bar = bar; b.x = xb_xcc_id(); b.st = st;
    if (threadIdx.x == 0) (void)xb_add(&bar[XB_XCNT(b.x)], 1u);
    return b;
}
__device__ __forceinline__ void xcd_barrier_complete(unsigned* bar, unsigned x, unsigned& nloc, unsigned& nx) {
    const unsigned G = gridDim.x * gridDim.y * gridDim.z;
    unsigned sum, cnt, mine, sp = 0u;
    for (;;) {
        sum = 0u; cnt = 0u; mine = 0u;
#pragma unroll
        for (unsigned j = 0; j < 16; ++j) { const unsigned c = xb_ld(&bar[XB_XCNT(j)]); sum += c; cnt += (c > 0u) ? 1u : 0u; mine = (j == x) ? c : mine; }
        if (sum == G) break;
        __builtin_amdgcn_s_sleep(1);
        if ((++sp & 255u) == 0u) { if (xb_ld(&bar[XB_TMO])) break; if (sp > XB_SPIN_CAP) { atomicAdd(&bar[XB_TMO], 1u); break; } }
    }
    nloc = mine > 0u ? mine : 1u; nx = cnt > 0u ? cnt : 1u;
}

__device__ __forceinline__ void xcd_barrier(const XcdBarrier& b) {
    asm volatile("s_waitcnt vmcnt(0)" ::: "memory");
    __syncthreads();
    if (threadIdx.x == 0) {
        unsigned* bar = b.bar;
        __builtin_amdgcn_s_waitcnt(0);
        unsigned nloc = b.st[0], nx = b.st[1];
        if (nloc == 0u) { xcd_barrier_complete(bar, b.x, nloc, nx); b.st[0] = nloc; b.st[1] = nx; }
        const unsigned old = xb_add(&bar[XB_XSUB(b.x)], 1u);
        const unsigned gen = old / nloc;
        if (old + 1u == (gen + 1u) * nloc) {
            __builtin_amdgcn_fence(__ATOMIC_RELEASE, "agent");
            asm volatile("s_waitcnt vmcnt(0)" ::: "memory");
            const unsigned og = xb_add(&bar[XB_TOP], 1u);
            const unsigned tg = og / nx;
            if (og + 1u == (tg + 1u) * nx) xb_add(&bar[XB_TOPGEN], 1u);
            else XB_SPIN(xb_ld(&bar[XB_TOPGEN]) == tg, bar);
            __builtin_amdgcn_fence(__ATOMIC_ACQUIRE, "agent");
            xb_add(&bar[XB_XGEN(b.x)], 1u);
            asm volatile("s_waitcnt vmcnt(0)" ::: "memory");
        } else {
            XB_SPIN(xb_ld(&bar[XB_XGEN(b.x)]) == gen, bar);
            __builtin_amdgcn_fence(__ATOMIC_ACQUIRE, "agent");
            asm volatile("s_waitcnt vmcnt(0)" ::: "memory");
        }
    }
    __syncthreads();
}

__device__ __forceinline__ int mixa_row(int L0) { const int w = L0 >> 10, ch = L0 & 1023; return w == 0 ? 2048 + ch : 256 * (ch >> 7) + 128 * (w - 1) + (ch & 127); }
__device__ __forceinline__ int map_row(int kind, int n) { const int n0 = n & ~31; return (kind == 0 ? n0 : kind == 2 ? ffnup_row(n0) : kind == 3 ? mixa_row(n0) : headperm_row(n0)) + (n & 31); }
__device__ __forceinline__ void tr_item128(const float* W, int ldw, int k0, int n0, const float* gain, bf16* WT, int Kd, int kind, int noff, LAS float* scr, int lane) {
    const int cl = 4 * (lane & 31), kh = lane >> 5;
    f32x4 v[16];
#pragma unroll
    for (int i = 0; i < 16; ++i) v[i] = *(const f32x4*)(W + (size_t)(k0 + 2 * i + kh) * ldw + n0 + cl);
#pragma unroll
    for (int i = 0; i < 16; ++i) { f32x4 t = v[i]; if (gain) t = t * gain[k0 + 2 * i + kh]; *(LAS f32x4*)(scr + (2 * i + kh) * 132 + cl) = t; }
    LDS_WAIT(); asm volatile("" ::: "memory");
    const int c = lane & 3;
#pragma unroll
    for (int j = 0; j < 8; ++j) { const int n = (lane >> 2) + 16 * j; const LAS float* s = scr + (8 * c) * 132 + n;
        v4u o; o.x = pk2(s[0 * 132], s[1 * 132]); o.y = pk2(s[2 * 132], s[3 * 132]); o.z = pk2(s[4 * 132], s[5 * 132]); o.w = pk2(s[6 * 132], s[7 * 132]);
        *(v4u*)(WT + (size_t)map_row(kind, noff + n0 + n) * Kd + k0 + 8 * c) = o; }
    LDS_WAIT(); asm volatile("" ::: "memory");
}

struct Args { const float* in[16]; float* out; unsigned char* ws; int ph_lo, ph_hi; };

__global__ void __launch_bounds__(NTHREADS, 2) yoco_fwd(Args args) {
    extern __shared__ __attribute__((aligned(16))) unsigned char lds[];
    cg::grid_group grid = cg::this_grid();
    LAS unsigned char* ldsl = (LAS unsigned char*)lds;
    const int tid0 = threadIdx.x, wave = __builtin_amdgcn_readfirstlane(tid0 >> 6);
    const int G = gridDim.x, bx = blockIdx.x, vcu = (G % 8 == 0) ? (bx % 8) * (G / 8) + bx / 8 : bx;
    const int gw = vcu * NWAVES + wave, NGW = G * NWAVES;
    typedef __attribute__((address_space(4))) const unsigned char* kptr_t;
    const kptr_t kargs = (kptr_t)__builtin_amdgcn_kernarg_segment_ptr();
#define ARG_IN(i) (*(const float* const volatile __attribute__((address_space(4)))*)(kargs + 8 * (i)))
#define ARG_OUT (*(float* const volatile __attribute__((address_space(4)))*)(kargs + 128))
#define ARG_WS (*(unsigned char* const volatile __attribute__((address_space(4)))*)(kargs + 136))
#define x_in ARG_IN(0)
#define attn_norm ARG_IN(1)
#define ffn_norm ARG_IN(2)
#define a_w_in ARG_IN(3)
#define a_conv ARG_IN(4)
#define a_w_out ARG_IN(5)
#define kv_norm ARG_IN(6)
#define w_kvf ARG_IN(7)
#define b_f ARG_IN(8)
#define k_norm ARG_IN(9)
#define b_w_qg ARG_IN(10)
#define q_norm ARG_IN(11)
#define b_w_out ARG_IN(12)
#define ffn_w_up ARG_IN(13)
#define ffn_conv ARG_IN(14)
#define ffn_w_down ARG_IN(15)
#define PTRS() int tid; asm volatile("v_mbcnt_lo_u32_b32 %0, -1, 0\n\tv_mbcnt_hi_u32_b32 %0, -1, %0" : "=v"(tid)); tid += wave * 64; const int lane = tid & 63; (void)lane; unsigned char* const ws = ARG_WS; float* const X = ARG_OUT; float* const SSQ = (float*)(ws + WS_CT); \
    bf16* const WF = (bf16*)(ws + WS_WF); bf16* const XB = (bf16*)(ws + WS_XB); bf16* const KB = (bf16*)(ws + WS_K); bf16* const VB = (bf16*)(ws + WS_V); bf16* const GB = KB; \
    bf16* const QO = (bf16*)(ws + WS_ACT); bf16* const SG = (bf16*)(ws + WS_SG); bf16* const HB = (bf16*)(ws + WS_ACT); bf16* const PROJ = (bf16*)(ws + WS_ACT); \
    float* const EDGEA = (float*)(ws + WS_EDGEA); float* const EDGEG = (float*)(ws + WS_EDGEG); float* const FLT = (float*)(ws + WS_FLT); float* const CT = (float*)(ws + WS_CT); \
    (void)X; (void)SSQ; (void)WF; (void)XB; (void)KB; (void)VB; (void)GB; (void)QO; (void)SG; (void)HB; (void)PROJ; (void)EDGEA; (void)EDGEG; (void)FLT; (void)CT;
    const int lo = args.ph_lo, hi = args.ph_hi; int ph = 0;
#define ON() (lo <= ph && ph < hi)
    volatile LAS unsigned* const bst = (volatile LAS unsigned*)(ldsl + LDS_BARST);
    if (tid0 < 2) bst[tid0] = 0u;
    __syncthreads();
#define SEAM() do { if (lo <= ph && ph + 1 < hi) { if (ph == 0) { grid.sync(); (void)xcd_barrier_post((unsigned*)(ARG_WS + WS_CTL), bst); } else { XcdBarrier xb_; xb_.bar = (unsigned*)(ARG_WS + WS_CTL); xb_.x = xb_xcc_id(); xb_.st = bst; xcd_barrier(xb_); } } ++ph; } while (0)

    if (ON()) { PTRS();
        if (bx == 0) for (int i = tid; i < (int)(CTL_BYTES / 4); i += NTHREADS) ((unsigned*)(ws + WS_CTL))[i] = 0u;
#pragma nounroll
      for (int rp = 0; rp < ((PROBE_X & 16) ? 2 : 1); ++rp) {
        LAS float* scr = (LAS float*)(ldsl + wave * 16896);
        constexpr int NITEMS = 2 * 768 + 2 * 256 + 512 + 512 + 16 + 512 + 2 * 256 + 4 * 1408 + 4 * 704;
        for (int it = gw; it < NITEMS; it += NGW) {
            int r = it;
            if (r < 1536) { const int l = r / 768; r %= 768; const int kb = r / 24, nb = r % 24;
                tr_item128(a_w_in + (size_t)l * D * 3 * D, 3 * D, 32 * kb, 128 * nb, attn_norm + l * D, (bf16*)(ws + WS_WIN) + (size_t)l * 3 * D * D, D, 3, 0, scr, lane); continue; } r -= 1536;
            if (r < 512) { const int l = r / 256; r %= 256; const int kb = r / 8, nb = r % 8;
                tr_item128(a_w_out + (size_t)l * D * D, D, 32 * kb, 128 * nb, nullptr, (bf16*)(ws + WS_WOUT) + (size_t)l * D * D, D, 0, 0, scr, lane); continue; } r -= 512;
            if (r < 512) { const int kb = r / 16, nb = r % 16;
                tr_item128(b_w_qg, 2 * D, 32 * kb, 128 * nb, attn_norm + 2 * D, (bf16*)(ws + WS_WQGKV), D, 1, 0, scr, lane); continue; } r -= 512;
            if (r < 512) { const int kb = r / 16, nb = r % 16;
                tr_item128(w_kvf, 2 * D + H, 32 * kb, 128 * nb, kv_norm, (bf16*)(ws + WS_WQGKV), D, 1, 2048, scr, lane); continue; } r -= 512;
            if (r < 16) { tr_item(w_kvf, 2 * D + H, 64 * r, 2 * D, kv_norm, WF, D, 0, 16, scr, lane); continue; } r -= 16;
            if (r < 512) { const int kb = r / 16, nb = r % 16;
                tr_item128(b_w_qg + (size_t)D * 2 * D, 2 * D, 32 * kb, 128 * nb, attn_norm + 3 * D, (bf16*)(ws + WS_WQG3), D, 1, 0, scr, lane); continue; } r -= 512;
            if (r < 512) { const int l = r / 256; r %= 256; const int kb = r / 8, nb = r % 8;
                tr_item128(b_w_out + (size_t)l * D * D, D, 32 * kb, 128 * nb, nullptr, (bf16*)(ws + WS_WBO) + (size_t)l * D * D, D, 0, 0, scr, lane); continue; } r -= 512;
            if (r < 4 * 1408) { const int l = r / 1408; r %= 1408; const int kb = r / 44, nb = r % 44;
                tr_item128(ffn_w_up + (size_t)l * D * 2 * FF, 2 * FF, 32 * kb, 128 * nb, ffn_norm + l * D, (bf16*)(ws + WS_WUP) + (size_t)l * 2 * FF * D, D, 2, 0, scr, lane); continue; } r -= 4 * 1408;
            { const int l = r / 704; r %= 704; const int kb = r / 8, nb = r % 8;
                tr_item128(ffn_w_down + (size_t)l * FF * D, D, 32 * kb, 128 * nb, nullptr, (bf16*)(ws + WS_WDN) + (size_t)l * D * FF, FF, 0, 0, scr, lane); }
        }
        for (int m0 = gw; m0 < M; m0 += 2 * NGW) {
            const int m1 = (m0 + NGW < M) ? m0 + NGW : m0;
            const f32x4* xr0 = (const f32x4*)(x_in + (size_t)m0 * D) + lane; const f32x4* xr1 = (const f32x4*)(x_in + (size_t)m1 * D) + lane; f32x4 v0[4], v1[4]; float s0 = 0.f, s1 = 0.f;
#pragma unroll
            for (int j = 0; j < 4; ++j) { v0[j] = xr0[64 * j]; v1[j] = xr1[64 * j]; }
#pragma unroll
            for (int j = 0; j < 4; ++j) { s0 += (v0[j].x * v0[j].x + v0[j].y * v0[j].y) + (v0[j].z * v0[j].z + v0[j].w * v0[j].w); s1 += (v1[j].x * v1[j].x + v1[j].y * v1[j].y) + (v1[j].z * v1[j].z + v1[j].w * v1[j].w); }
            s0 = wave_sum(s0); s1 = wave_sum(s1);
            v2u* o80 = (v2u*)(XB + (size_t)m0 * D) + lane; v2u* o81 = (v2u*)(XB + (size_t)m1 * D) + lane;
#pragma unroll
            for (int j = 0; j < 4; ++j) { v2u o; o.x = pk2(v0[j].x, v0[j].y); o.y = pk2(v0[j].z, v0[j].w); o80[64 * j] = o; }
            if (lane < 4) SSQ[(size_t)m0 * 4 + lane] = lane == 0 ? s0 : 0.f;
            if (m1 != m0) {
#pragma unroll
                for (int j = 0; j < 4; ++j) { v2u o; o.x = pk2(v1[j].x, v1[j].y); o.y = pk2(v1[j].z, v1[j].w); o81[64 * j] = o; }
                if (lane < 4) SSQ[(size_t)m1 * 4 + lane] = lane == 0 ? s1 : 0.f; }
        }
      }
    }
    SEAM();

#pragma nounroll
    for (int l = 0; l < 4; ++l) {
#pragma nounroll
        for (int half = 0; half < 2; ++half) {
            if (half == 0) {
                if (l < 2) {
                    if (ON()) { PTRS(); const float* ssq_in = SSQ; pg8::Gemm g{XB, (const bf16*)(ws + WS_WIN) + (size_t)l * 3 * D * D, M, 3 * D, D}; pg8::StaticOrder S; S.init(M, 3 * D, G, bx, (PROBE_X & 4) ? 2 : 1);
                        pg8::EpiMixA E{PROJ, PROJ + (size_t)M * D, ssq_in};
                        pg8::gemm_phase<pg8::EpiMixA, pg8::StaticOrder, true, true>(ldsl, g, S, E, tid); }
                    SEAM();
                    if (ON()) { PTRS();
                        const float* cw = a_conv + (size_t)l * 3 * D; const bf16* Bo = PROJ; const bf16* CHp = PROJ + (size_t)M * D;
                        for (int item = vcu * NTHREADS + tid; item < (M / 32) * 128; item += G * NTHREADS) {
                            const int cgp = item & 127, r0 = (item >> 7) * 32, c0 = 8 * cgp;
                            float w0[8], w1[8], w2[8], p1[8], p2[8];
#pragma unroll
                            for (int e = 0; e < 8; ++e) { w0[e] = cw[c0 + e]; w1[e] = cw[D + c0 + e]; w2[e] = cw[2 * D + c0 + e]; p1[e] = 0.f; p2[e] = 0.f; }
                            if ((r0 & (T - 1)) != 0) {
                                const v4u c2 = *(const v4u*)(CHp + (size_t)(r0 - 2) * D + c0), c1 = *(const v4u*)(CHp + (size_t)(r0 - 1) * D + c0);
#pragma unroll
                                for (int k = 0; k < 4; ++k) { p2[2 * k] = bflo(c2[k]); p2[2 * k + 1] = bfhi(c2[k]); p1[2 * k] = bflo(c1[k]); p1[2 * k + 1] = bfhi(c1[k]); }
                            }
#pragma nounroll
                            for (int r = r0; r < r0 + 32; r += 8) {
                                v4u bb[8], cc[8];
#pragma unroll
                                for (int i = 0; i < 8; ++i) { bb[i] = *(const v4u*)(Bo + (size_t)(r + i) * D + c0); cc[i] = *(const v4u*)(CHp + (size_t)(r + i) * D + c0); }
#pragma unroll
                                for (int i = 0; i < 8; ++i) {
                                    float ch[8], o[8];
#pragma unroll
                                    for (int k = 0; k < 4; ++k) { ch[2 * k] = bflo(cc[i][k]); ch[2 * k + 1] = bfhi(cc[i][k]); }
#pragma unroll
                                    for (int e = 0; e < 8; ++e) { const float u = w0[e] * p2[e] + w1[e] * p1[e] + w2[e] * ch[e]; p2[e] = p1[e]; p1[e] = ch[e]; o[e] = u; }
                                    v4u ov;
#pragma unroll
                                    for (int k = 0; k < 4; ++k) ov[k] = pk2(bflo(bb[i][k]) * o[2 * k], bfhi(bb[i][k]) * o[2 * k + 1]);
                                    *(v4u*)(GB + (size_t)(r + i) * D + c0) = ov;
                                }
                            }
                        }
                    }
                    SEAM();
                } else {
                    if (ON()) { PTRS(); const float* ssq_in = SSQ;
                        const int j = l - 2, N = (l == 2) ? 4 * D : 2 * D;
                        pg8::Gemm g{XB, (const bf16*)(ws + (l == 2 ? WS_WQGKV : WS_WQG3)), M, N, D}; pg8::StaticOrder S; S.init(M, N, G, bx, (PROBE_X & 4) ? 2 : 1);
                        pg8::EpiQG E{QO, SG, KB, VB, ssq_in, q_norm + j * HD, k_norm, attn_body::C2};
                        pg8::gemm_phase<pg8::EpiQG, pg8::StaticOrder, true, true>(ldsl, g, S, E, tid);
                        if (l == 2) {
                            for (int rg = gw; rg < M / 16; rg += NGW) {
                                f32x4 acc = (f32x4){0.f, 0.f, 0.f, 0.f};
                                const bf16* wp = WF + (size_t)(lane & 15) * D + 8 * (lane >> 4); const bf16* xp = XB + (size_t)(16 * rg + (lane & 15)) * D + 8 * (lane >> 4);
#pragma unroll 8
                                for (int kt = 0; kt < 32; ++kt) { const bf16x8 wa = *(const bf16x8*)(wp + 32 * kt), xa = *(const bf16x8*)(xp + 32 * kt); acc = __builtin_amdgcn_mfma_f32_16x16x32_bf16(wa, xa, acc, 0, 0, 0); }
                                const int row = 16 * rg + (lane & 15), bb = row / T, s = row % T; const float rs = pg8::rstd_of(ssq_in, row);
#pragma unroll
                                for (int e = 0; e < 4; ++e) { const int hd = 4 * (lane >> 4) + e; const float z = acc[e] * rs + b_f[hd];
                                    const float ls = fminf(z, 0.f) - log1pf(expf(-fabsf(z))); FLT[(size_t)(bb * H + hd) * T + s] = ls; }
                            }
                        }
                    }
                    SEAM();
                    if (l == 2) {
                        if (ON()) { PTRS();
                            for (int bh = vcu; bh < BATCH * H; bh += G) {
                                const f32x4* src = (const f32x4*)(FLT + (size_t)bh * T + 16 * tid); f32x4 v[4]; float run = 0.f;
#pragma unroll
                                for (int q = 0; q < 4; ++q) { v[q] = src[q]; v[q].x += run; v[q].y += v[q].x; v[q].z += v[q].y; v[q].w += v[q].z; run = v[q].w; }
                                float inc = run;
#pragma unroll
                                for (int o = 1; o < 64; o <<= 1) { const float t = __shfl_up(inc, o); if (lane >= o) inc += t; }
                                LAS float* wsum = (LAS float*)ldsl;
                                __syncthreads();
                                if (lane == 63) wsum[wave] = inc;
                                __syncthreads();
                                float off = inc - run;
                                for (int w = 0; w < wave; ++w) off += wsum[w];
                                LAS float* cl = (LAS float*)(ldsl + 1024);
                                v2u* kxg = (v2u*)(X) + (size_t)bh * T + 16 * tid;
#pragma unroll
                                for (int q = 0; q < 4; ++q) { const f32x4 c4 = (v[q] + off) * 1.4426950408889634f; *(LAS f32x4*)(cl + 16 * tid + 4 * q) = c4;
#pragma unroll
                                    for (int e = 0; e < 4; ++e) { const float bb = -c4[e]; const unsigned h_ = f2bf(bb); const float r1 = bb - __builtin_bit_cast(float, h_ << 16);
                                        const unsigned m_ = f2bf(r1); const float r2 = r1 - __builtin_bit_cast(float, m_ << 16); v2u w; w.x = h_ | (m_ << 16); w.y = f2bf(r2) | 0x3f800000u; kxg[4 * q + e] = w; } }
                                __syncthreads();
                                float gk = fabsf(k_norm[lane]), gq0 = fabsf(q_norm[lane]), gq1 = fabsf(q_norm[HD + lane]);
#pragma unroll
                                for (int o = 1; o < 64; o <<= 1) { gk = fmaxf(gk, __shfl_xor(gk, o)); gq0 = fmaxf(gq0, __shfl_xor(gq0, o)); gq1 = fmaxf(gq1, __shfl_xor(gq1, o)); }
                                const int qb = tid >> 4, jj = tid & 15, NT0 = 4 * qb + 4; const float cq = cl[256 * qb];
#pragma unroll
                                for (int ly = 0; ly < 2; ++ly) {
                                    const float TH = 2.0f * (8.0f * (ly == 0 ? gq0 : gq1) * gk * 1.4426950408889634f * 1.05f) + 160.0f;
                                    int j0 = NT0 - 4;
                                    for (int j = jj; j < NT0; j += 16) if (cq - cl[64 * j + 63] >= -TH) { j0 = min(j0, j); break; }
#pragma unroll
                                    for (int o = 1; o < 16; o <<= 1) j0 = min(j0, __shfl_xor(j0, o));
                                    if (jj == 0) ((unsigned*)(X + 2 * 1024 * 1024))[(ly * BATCH * H + bh) * 32 + qb] = (unsigned)(j0 & ~1);
                                }
                                __syncthreads();
                            }
                        }
                        SEAM();
                    }
                    if (ON()) { PTRS();
                        float gq = fabsf(q_norm[(l - 2) * HD + lane]), gk = fabsf(k_norm[lane]);
#pragma unroll
                        for (int o = 1; o < 64; o <<= 1) { gq = fmaxf(gq, __shfl_xor(gq, o)); gk = fmaxf(gk, __shfl_xor(gk, o)); }
                        const float BND = 8.0f * gq * gk * 1.4426950408889634f * 1.05f;
#pragma nounroll
                        for (int rp = 0; rp < ((PROBE_X & 2) ? 2 : 1); ++rp) {
                            const attn_body::AttnTensors AT{(const attn_body::bf16*)QO, (const attn_body::bf16*)KB, (const attn_body::bf16*)VB, (attn_body::bf16*)(((PROBE_X & 2) && rp == 0) ? ws + WS_ACT + 128 * MiB : ws + WS_ACT), (const attn_body::bf16*)SG, (const unsigned*)X, (const unsigned*)(X + 2 * 1024 * 1024) + (l - 2) * BATCH * H * 32};
                            unsigned* const qctr = (unsigned*)(ws + WS_CTL) + 3584 + 64 * (l - 2) + 128 * rp;
                            attn_body::attn_phase<40>((char*)lds, AT, qctr, BND, tid, (PROBE_X & 32) && rp == 0); __syncthreads(); }
                    }
                    SEAM();
                }
            } else {
                if (ON()) { PTRS(); const float* ssq_in = SSQ; pg8::Gemm g{XB, (const bf16*)(ws + WS_WUP) + (size_t)l * 2 * FF * D, M, 2 * FF, D}; pg8::StaticOrder S; S.init(M, 2 * FF, G, bx, (PROBE_X & 1) ? 2 : 1);
                    pg8::EpiFfnUp E{HB, ssq_in, ffn_conv + (size_t)l * 3 * FF, EDGEA, EDGEG};
pg8::gemm_phase<pg8::EpiFfnUp, pg8::StaticOrder, true, true>(ldsl, g, S, E, tid); }
                SEAM();
            }
            if (ON()) { PTRS(); float* ssq_out = SSQ;
                const bf16* A = half == 1 ? HB : (l < 2 ? GB : QO);
                const bf16* Bt = half == 1 ? (const bf16*)(ws + WS_WDN) + (size_t)l * D * FF : (l < 2 ? (const bf16*)(ws + WS_WOUT) + (size_t)l * D * D : (const bf16*)(ws + WS_WBO) + (size_t)(l - 2) * D * D);
                pg8::Gemm g{A, Bt, M, D, half == 1 ? FF : D}; pg8::StaticOrder S; S.init(M, D, G, bx, (PROBE_X & 8) ? 2 : 1);
                if (half == 1) {
                    const float* cw = ffn_conv + (size_t)l * 3 * FF; pg8::Unit uu;
                    for (int ui = 0; S.next(ui, uu); ++ui) {
                        for (int item = tid; item < 4 * (FF / 4); item += NTHREADS) {
                            const int grp = 4 * uu.pm + item / (FF / 4), ch = 4 * (item % (FF / 4)); const bool first = ((grp * 64) & (T - 1)) == 0;
                            const f32x4 z4 = (f32x4){0.f, 0.f, 0.f, 0.f};
                            const f32x4 a0 = *(const f32x4*)(EDGEA + ((size_t)grp * 4 + 0) * FF + ch), a1 = *(const f32x4*)(EDGEA + ((size_t)grp * 4 + 1) * FF + ch);
                            const f32x4 pm2 = first ? z4 : *(const f32x4*)(EDGEA + ((size_t)(grp - 1) * 4 + 2) * FF + ch), pm1 = first ? z4 : *(const f32x4*)(EDGEA + ((size_t)(grp - 1) * 4 + 3) * FF + ch);
                            const f32x4 g0 = *(const f32x4*)(EDGEG + ((size_t)grp * 2 + 0) * FF + ch), g1 = *(const f32x4*)(EDGEG + ((size_t)grp * 2 + 1) * FF + ch);
                            const f32x4 w0 = *(const f32x4*)(cw + ch), w1 = *(const f32x4*)(cw + FF + ch), w2 = *(const f32x4*)(cw + 2 * FF + ch);
                            const f32x4 c0 = w0 * pm2 + w1 * pm1 + w2 * a0, c1 = w0 * pm1 + w1 * a0 + w2 * a1; f32x4 h0, h1;
#pragma unroll
                            for (int e = 0; e < 4; ++e) { h0[e] = c0[e] * pg8::sigmoidf_fast(c0[e]) * g0[e]; h1[e] = c1[e] * pg8::sigmoidf_fast(c1[e]) * g1[e]; }
                            v2u o0, o1; o0.x = pk2(h0[0], h0[1]); o0.y = pk2(h0[2], h0[3]); o1.x = pk2(h1[0], h1[1]); o1.y = pk2(h1[2], h1[3]);
                            *(v2u*)(HB + (size_t)(grp * 64) * FF + ch) = o0; *(v2u*)(HB + (size_t)(grp * 64 + 1) * FF + ch) = o1;
                        }
                    }
                    asm volatile("s_waitcnt vmcnt(0)" ::: "memory"); __syncthreads();
                }
pg8::EpiRes E{(l == 0 && half == 0) ? x_in : (const float*)nullptr, (l == 3 && half == 1) ? X : (float*)nullptr, XB, ssq_out, (LAS float*)(ldsl + RING_BYTES), (PROBE_X & 8) ? 2 : 1};
                pg8::gemm_phase<pg8::EpiRes, pg8::StaticOrder, true, true>(ldsl, g, S, E, tid);
            }
            SEAM();
        }
    }
#undef ON
#undef SEAM
#undef PTRS
#undef x_in
#undef attn_norm
#undef ffn_norm
#undef a_w_in
#undef a_conv
#undef a_w_out
#undef kv_norm
#undef w_kvf
#undef b_f
#undef k_norm
#undef b_w_qg
#undef q_norm
#undef b_w_out
#undef ffn_w_up
#undef ffn_conv
#undef ffn_w_down
}

extern "C" void kernel_launch(void* const* d_in, const int* in_sizes, int n_in, void* d_out, int out_size, void* d_ws, size_t ws_size, hipStream_t stream) {
    static int grid = 0;
    if (grid == 0) {
        if (n_in != 16 || in_sizes[0] != M * D || out_size != M * D || ws_size < WS_END) { fprintf(stderr, "kernel_launch: unexpected shapes: n_in %d in0 %d out %d ws %zu (need %zu)\n", n_in, n_in > 0 ? in_sizes[0] : -1, out_size, ws_size, (size_t)WS_END); grid = -1; return; }
        int dev = 0, cus = 0, per_cu = 0;
        if (hipGetDevice(&dev) != hipSuccess || hipDeviceGetAttribute(&cus, hipDeviceAttributeMultiprocessorCount, dev) != hipSuccess) { grid = -1; return; }
        if (hipFuncSetAttribute((const void*)yoco_fwd, hipFuncAttributeMaxDynamicSharedMemorySize, LDS_BYTES) != hipSuccess) { fprintf(stderr, "kernel_launch: hipFuncSetAttribute failed\n"); grid = -1; return; }
        if (hipOccupancyMaxActiveBlocksPerMultiprocessor(&per_cu, (const void*)yoco_fwd, NTHREADS, LDS_BYTES) != hipSuccess || per_cu < 1) { fprintf(stderr, "kernel_launch: occupancy query says %d blocks per CU\n", per_cu); per_cu = 1; }
        (void)hipGetLastError();
        grid = cus * per_cu;
        fprintf(stderr, "kernel_launch: grid %d (%d CUs x %d)\n", grid, cus, per_cu);
    }
    if (grid < 0) return;
#if MK_MULTI
    if (hipMemsetAsync((char*)d_ws + WS_CTL, 0, CTL_BYTES, stream) != hipSuccess) { fprintf(stderr, "kernel_launch: memset failed\n"); return; }
#endif
    Args a{};
    for (int i = 0; i < 16; ++i) a.in[i] = (const float*)d_in[i];
    a.out = (float*)d_out; a.ws = (unsigned char*)d_ws;
#if MK_MULTI
    for (int p = 0; p < N_PHASES; ++p) { a.ph_lo = p; a.ph_hi = p + 1; hipLaunchKernelGGL(yoco_fwd, dim3(grid), dim3(NTHREADS), LDS_BYTES, stream, a); }
#else
    a.ph_lo = 0; a.ph_hi = N_PHASES;
    void* kargs[] = {&a};
    const hipError_t e = hipLaunchCooperativeKernel((const void*)yoco_fwd, dim3(grid), dim3(NTHREADS), kargs, LDS_BYTES, stream);
    if (e != hipSuccess) fprintf(stderr, "kernel_launch: cooperative launch failed: %s (grid %d)\n", hipGetErrorString(e), grid);
#endif
}
```
